# Optimizing an MI355X kernel written in HIP

```python
import math
import jax, jax.numpy as jnp
from jax import lax
import numpy as np

D_MODEL = 1024
BATCH = 4
SEQ = 8192
DEPTH = 1
DEC_BATCH = 128
DEC_SEQ = 8
PAST_LEN = 16384
PAGE_SIZE = 128

HEAD_DIM = 64
MIX_WIDTH = D_MODEL
ATT_HEADS = MIX_WIDTH // (2 * HEAD_DIM)
ATT_KV_HEADS = ATT_HEADS // 4
ATT_GROUP = ATT_HEADS // ATT_KV_HEADS
WINDOW = 128
ATT_BLOCK = WINDOW
ATT_Q = ATT_HEADS * HEAD_DIM
ATT_KV = ATT_KV_HEADS * HEAD_DIM
DN_HEADS = 8
DN_DK = HEAD_DIM
DN_DV = HEAD_DIM
DN_WIDTH = DN_HEADS * DN_DV
DN_QKV = 2 * DN_HEADS * DN_DK + DN_WIDTH
CONV_W = 4
DN_CHUNK = 64
IN_WIDTH = ATT_Q + 2 * ATT_KV + DN_QKV + DN_WIDTH + 2 * DN_HEADS
N_KEYS = 128
N_EXPERTS = N_KEYS * N_KEYS
PEER_HEADS = 8
PEER_QDIM = 256
PEER_TOPK = 16
PEER_BLOCK = 256
PLE_DIM = 256
EPS = 1e-6

kernel_name = 'hymba_swa_gdn_peer_step'


def rmsnorm(x, g):
    xf = x.astype(jnp.float32)
    y = xf * lax.rsqrt(jnp.mean(xf * xf, axis=-1, keepdims=True) + EPS)
    return (y * g.astype(jnp.float32)).astype(x.dtype)


def l2norm(x):
    return x * lax.rsqrt(jnp.sum(x * x, axis=-1, keepdims=True) + EPS)


def alibi_slopes():
    h = jnp.arange(1, ATT_HEADS + 1, dtype=jnp.float32)
    return jnp.exp2(-8.0 * h / ATT_HEADS)


def _attend(q, k, v, dist, valid, sinks):
    s = jnp.einsum('bnqhgd,bnkhd->bnhgqk', q, k).astype(jnp.float32) * (HEAD_DIM ** -0.5)
    slopes = alibi_slopes().reshape(ATT_KV_HEADS, ATT_GROUP)[None, None, :, :, None, None]
    s = s - slopes * dist.astype(jnp.float32)[None, :, None, None]
    s = jnp.where(valid[None, :, None, None], s, -jnp.inf)
    sink = sinks.astype(jnp.float32).reshape(ATT_KV_HEADS, ATT_GROUP)[None, None, :, :, None, None]
    m = jnp.maximum(jnp.max(s, axis=-1, keepdims=True), sink)
    e = jnp.exp(s - m)
    probs = e / (jnp.sum(e, axis=-1, keepdims=True) + jnp.exp(sink - m))
    return jnp.einsum('bnhgqk,bnkhd->bnqhgd', probs.astype(v.dtype), v)


def swa_prompt(q, k, v, sinks):
    B, L = q.shape[0], q.shape[1]
    N = L // ATT_BLOCK
    qb = q.reshape(B, N, ATT_BLOCK, ATT_KV_HEADS, ATT_GROUP, HEAD_DIM)

    def band(t):
        tp = jnp.pad(t, ((0, 0), (ATT_BLOCK, 0), (0, 0), (0, 0)))
        tp = tp.reshape(B, N + 1, ATT_BLOCK, ATT_KV_HEADS, HEAD_DIM)
        return jnp.concatenate([tp[:, :-1], tp[:, 1:]], axis=2)

    i = jnp.arange(ATT_BLOCK)[:, None]
    j = jnp.arange(2 * ATT_BLOCK)[None, :]
    dist = ATT_BLOCK + i - j
    kpos = jnp.arange(N)[:, None, None] * ATT_BLOCK - ATT_BLOCK + j[None]
    valid = (dist >= 0) & (dist <= WINDOW) & (kpos >= 0)
    out = _attend(qb, band(k), band(v), jnp.broadcast_to(dist, valid.shape), valid, sinks)
    return out.reshape(B, L, ATT_Q), k[:, -WINDOW:], v[:, -WINDOW:]


def swa_sample(q, k, v, k_buf, v_buf, sinks):
    B, L = q.shape[0], q.shape[1]
    kc = jnp.concatenate([k_buf.astype(k.dtype), k], axis=1)
    vc = jnp.concatenate([v_buf.astype(v.dtype), v], axis=1)
    dist = jnp.arange(L)[:, None] - (jnp.arange(WINDOW + L)[None, :] - WINDOW)
    valid = (dist >= 0) & (dist <= WINDOW)
    qb = q.reshape(B, 1, L, ATT_KV_HEADS, ATT_GROUP, HEAD_DIM)
    out = _attend(qb, kc[:, None], vc[:, None], dist[None], valid[None], sinks)
    return out.reshape(B, L, ATT_Q), kc[:, -WINDOW:], vc[:, -WINDOW:]


def causal_conv(x, prefix, w):
    L = x.shape[1]
    xp = jnp.concatenate([prefix.astype(x.dtype), x], axis=1)
    y = xp[:, 0:L] * w[0]
    for j in range(1, CONV_W):
        y = y + xp[:, j:j + L] * w[j]
    return jax.nn.silu(y), xp[:, -(CONV_W - 1):]


def gated_delta_rule(q, k, v, g, beta, s0):
    B, L, H, dk = q.shape
    dv = v.shape[-1]
    C = min(DN_CHUNK, L)
    pad = (-L) % C
    N = (L + pad) // C

    def chunks(t):
        t = jnp.pad(t, [(0, 0), (0, pad)] + [(0, 0)] * (t.ndim - 2))
        t = t.reshape((B, N, C) + t.shape[2:])
        return jnp.moveaxis(t, 3, 1)

    q, k, v, g, beta = chunks(q), chunks(k), chunks(v), chunks(g), chunks(beta)
    G = jnp.cumsum(g, axis=-1)
    idx = jnp.arange(C)
    lower = idx[:, None] >= idx[None, :]
    strict = idx[:, None] > idx[None, :]
    decay = jnp.exp(jnp.where(lower, G[..., :, None] - G[..., None, :], -jnp.inf))
    kb = k * beta[..., None]
    Lm = jnp.where(strict, jnp.einsum('bhnid,bhnjd->bhnij', kb, k) * decay, 0.0)
    M = Lm + jnp.eye(C, dtype=Lm.dtype)
    rhs = jnp.concatenate([v * beta[..., None], kb * jnp.exp(G)[..., None]], axis=-1)
    X = lax.linalg.triangular_solve(M, rhs, left_side=True, lower=True, unit_diagonal=True)
    u, w = X[..., :dv], X[..., dv:]
    qk = jnp.einsum('bhnid,bhnjd->bhnij', q, k) * decay
    g_last = G[..., -1]
    k_tail = k * jnp.exp(g_last[..., None] - G)[..., None]
    q_head = q * jnp.exp(G)[..., None]

    def step(S, xs):
        qh, kt, uc, wc, qkc, gl = xs
        v_new = uc - jnp.einsum('bhcd,bhde->bhce', wc, S)
        o = jnp.einsum('bhcd,bhde->bhce', qh, S) + jnp.einsum('bhij,bhje->bhie', qkc, v_new)
        S = S * jnp.exp(gl)[..., None, None] + jnp.einsum('bhcd,bhce->bhde', kt, v_new)
        return S, o

    xs = tuple(jnp.moveaxis(t, 2, 0) for t in (q_head, k_tail, u, w, qk, g_last))
    S, o = lax.scan(step, s0, xs)
    o = jnp.moveaxis(jnp.moveaxis(o, 0, 2), 1, 3).reshape(B, N * C, H, dv)[:, :L]
    return o, S


def delta_branch(qkv_raw, z, a_raw, b_raw, conv_prefix, s0, conv_w, a_log, dt_bias, dn_norm):
    B, L = qkv_raw.shape[0], qkv_raw.shape[1]
    qkv, conv_new = causal_conv(qkv_raw, conv_prefix, conv_w)
    q, k, v = jnp.split(qkv, [DN_HEADS * DN_DK, 2 * DN_HEADS * DN_DK], axis=-1)
    q = l2norm(q.reshape(B, L, DN_HEADS, DN_DK).astype(jnp.float32)) * (DN_DK ** -0.5)
    k = l2norm(k.reshape(B, L, DN_HEADS, DN_DK).astype(jnp.float32))
    v = v.reshape(B, L, DN_HEADS, DN_DV).astype(jnp.float32)
    beta = jax.nn.sigmoid(b_raw.astype(jnp.float32))
    g = -jnp.exp(a_log.astype(jnp.float32)) * jax.nn.softplus(a_raw.astype(jnp.float32) + dt_bias.astype(jnp.float32))
    o, s_new = gated_delta_rule(q, k, v, g, beta, s0.astype(jnp.float32))
    o = rmsnorm(o, dn_norm) * jax.nn.silu(z.reshape(B, L, DN_HEADS, DN_DV).astype(jnp.float32))
    return o.reshape(B, L, DN_WIDTH).astype(qkv_raw.dtype), conv_new, s_new


def hybrid_mixer(a, kv_buf, conv_prefix, s0, w_in, conv_w, sinks, a_log, dt_bias, dn_norm, w_out):
    B, L = a.shape[0], a.shape[1]
    proj = a @ w_in
    cuts = [ATT_Q, ATT_Q + ATT_KV, ATT_Q + 2 * ATT_KV, ATT_Q + 2 * ATT_KV + DN_QKV,
            ATT_Q + 2 * ATT_KV + DN_QKV + DN_WIDTH, ATT_Q + 2 * ATT_KV + DN_QKV + DN_WIDTH + DN_HEADS]
    qa, ka, va, dqkv, z, ar, br = jnp.split(proj, cuts, axis=-1)
    qa = qa.reshape(B, L, ATT_HEADS, HEAD_DIM)
    ka = ka.reshape(B, L, ATT_KV_HEADS, HEAD_DIM)
    va = va.reshape(B, L, ATT_KV_HEADS, HEAD_DIM)
    if kv_buf is None:
        att, k_new, v_new = swa_prompt(qa, ka, va, sinks)
    else:
        att, k_new, v_new = swa_sample(qa, ka, va, kv_buf[0], kv_buf[1], sinks)
    dn, conv_new, s_new = delta_branch(dqkv, z, ar, br, conv_prefix, s0, conv_w, a_log, dt_bias, dn_norm)
    out = jnp.concatenate([att, dn], axis=-1) @ w_out
    return out, k_new, v_new, conv_new, s_new


def peer(x, wq, keys1, keys2, u_tab, v_tab):
    B, L, D = x.shape
    T = B * L
    blk = min(PEER_BLOCK, T)
    pad = (-T) % blk
    xt = jnp.pad(x.reshape(T, D), ((0, pad), (0, 0))).reshape(-1, blk, D)
    half = PEER_QDIM // 2

    def block(xb):
        q = (xb @ wq).reshape(blk, PEER_HEADS, PEER_QDIM).astype(jnp.float32)
        s1 = jnp.einsum('thd,hnd->thn', q[..., :half], keys1.astype(jnp.float32))
        s2 = jnp.einsum('thd,hnd->thn', q[..., half:], keys2.astype(jnp.float32))
        v1, i1 = lax.top_k(s1, PEER_TOPK)
        v2, i2 = lax.top_k(s2, PEER_TOPK)
        cand = (v1[..., :, None] + v2[..., None, :]).reshape(blk, PEER_HEADS, PEER_TOPK * PEER_TOPK)
        sc, ci = lax.top_k(cand, PEER_TOPK)
        e1 = jnp.take_along_axis(i1, ci // PEER_TOPK, axis=-1)
        e2 = jnp.take_along_axis(i2, ci % PEER_TOPK, axis=-1)
        expert = e1 * N_KEYS + e2
        gate = jax.nn.softmax(sc, axis=-1)
        act = jax.nn.gelu(jnp.einsum('td,thkd->thk', xb, u_tab[expert]).astype(jnp.float32), approximate=False)
        return jnp.einsum('thk,thkd->td', (gate * act).astype(xb.dtype), v_tab[expert])

    y = lax.map(block, xt).reshape(-1, D)[:T]
    return y.reshape(B, L, D)


def decoder_layer(h, p_l, kv_buf, conv_prefix, s0, norm_mix, w_in, conv_w, sinks, a_log, dt_bias, dn_norm,
                  w_out, norm_ffn, peer_wq, keys1, keys2, peer_u, peer_v, norm_ple, ple_in, ple_gate):
    mix, k_new, v_new, conv_new, s_new = hybrid_mixer(rmsnorm(h, norm_mix), kv_buf, conv_prefix, s0, w_in,
                                                      conv_w, sinks, a_log, dt_bias, dn_norm, w_out)
    h = h + mix
    h = h + peer(rmsnorm(h, norm_ffn), peer_wq, keys1, keys2, peer_u, peer_v)
    gate = jax.nn.sigmoid((rmsnorm(h, norm_ple) @ ple_gate).astype(jnp.float32))
    h = h + ((p_l @ ple_in).astype(jnp.float32) * gate).astype(h.dtype)
    return h, k_new, v_new, conv_new, s_new


def setup_inputs(seed: int = 0) -> dict:
    key = jax.random.key(seed)
    ks = jax.random.split(key, 32)
    f32 = jnp.float32
    nrm = lambda k, shape, scale: jax.random.normal(k, shape, f32) * scale
    dt = jnp.exp(jax.random.uniform(ks[10], (DEPTH, DN_HEADS), f32, math.log(1e-3), math.log(1e-1)))
    return {
        'x_prompt': nrm(ks[0], (BATCH, SEQ, D_MODEL), 1.0),
        'x_sample': nrm(ks[1], (DEC_BATCH, DEC_SEQ, D_MODEL), 1.0),
        'p_prompt': nrm(ks[2], (DEPTH, BATCH, SEQ, PLE_DIM), 1.0),
        'p_sample': nrm(ks[3], (DEPTH, DEC_BATCH, DEC_SEQ, PLE_DIM), 1.0),
        'cache_swa_k': nrm(ks[4], (DEPTH, DEC_BATCH, WINDOW, ATT_KV_HEADS, HEAD_DIM), 1.0),
        'cache_swa_v': nrm(ks[5], (DEPTH, DEC_BATCH, WINDOW, ATT_KV_HEADS, HEAD_DIM), 1.0),
        'state_conv': nrm(ks[6], (DEPTH, DEC_BATCH, CONV_W - 1, DN_QKV), 1.0),
        'state_delta': nrm(ks[7], (DEPTH, DEC_BATCH, DN_HEADS, DN_DK, DN_DV), DN_DK ** -0.5),
        'norm_mix': 1.0 + nrm(ks[8], (DEPTH, D_MODEL), 0.02),
        'w_in': nrm(ks[9], (DEPTH, D_MODEL, IN_WIDTH), D_MODEL ** -0.5),
        'conv_w': nrm(ks[11], (DEPTH, CONV_W, DN_QKV), 0.5),
        'attn_sinks': nrm(ks[12], (DEPTH, ATT_HEADS), 0.5),
        'dn_a_log': jnp.log(jax.random.uniform(ks[13], (DEPTH, DN_HEADS), f32, 1.0, 16.0)),
        'dn_dt_bias': dt + jnp.log(-jnp.expm1(-dt)),
        'dn_norm': 1.0 + nrm(ks[14], (DEPTH, DN_DV), 0.02),
        'w_out': nrm(ks[15], (DEPTH, MIX_WIDTH, D_MODEL), MIX_WIDTH ** -0.5),
        'norm_ffn': 1.0 + nrm(ks[16], (DEPTH, D_MODEL), 0.02),
        'peer_wq': nrm(ks[17], (DEPTH, D_MODEL, PEER_HEADS * PEER_QDIM), D_MODEL ** -0.5),
        'peer_keys1': nrm(ks[18], (DEPTH, PEER_HEADS, N_KEYS, PEER_QDIM // 2), (PEER_QDIM // 2) ** -0.5),
        'peer_keys2': nrm(ks[19], (DEPTH, PEER_HEADS, N_KEYS, PEER_QDIM // 2), (PEER_QDIM // 2) ** -0.5),
        'peer_u': nrm(ks[20], (DEPTH, N_EXPERTS, D_MODEL), D_MODEL ** -0.5),
        'peer_v': nrm(ks[21], (DEPTH, N_EXPERTS, D_MODEL), 0.25),
        'norm_ple': 1.0 + nrm(ks[22], (DEPTH, D_MODEL), 0.02),
        'ple_in': nrm(ks[23], (DEPTH, PLE_DIM, D_MODEL), PLE_DIM ** -0.5),
        'ple_gate': nrm(ks[24], (DEPTH, D_MODEL, D_MODEL), D_MODEL ** -0.5),
        'norm_final': 1.0 + nrm(ks[25], (D_MODEL,), 0.02),
    }


def reference(x_prompt, x_sample, p_prompt, p_sample, cache_swa_k, cache_swa_v, state_conv, state_delta,
              norm_mix, w_in, conv_w, attn_sinks, dn_a_log, dn_dt_bias, dn_norm, w_out, norm_ffn,
              peer_wq, peer_keys1, peer_keys2, peer_u, peer_v, norm_ple, ple_in, ple_gate, norm_final):
    hp, hs = x_prompt, x_sample
    Bp = x_prompt.shape[0]
    kp_l, vp_l, cp_l, sp_l, ks_l, vs_l, cs_l, ss_l = [], [], [], [], [], [], [], []
    for l in range(DEPTH):
        w = (norm_mix[l], w_in[l], conv_w[l], attn_sinks[l], dn_a_log[l], dn_dt_bias[l], dn_norm[l],
             w_out[l], norm_ffn[l], peer_wq[l], peer_keys1[l], peer_keys2[l], peer_u[l], peer_v[l],
             norm_ple[l], ple_in[l], ple_gate[l])
        conv0 = jnp.zeros((Bp, CONV_W - 1, DN_QKV), x_prompt.dtype)
        s0 = jnp.zeros((Bp, DN_HEADS, DN_DK, DN_DV), jnp.float32)
        hp, kp, vp, cp, sp = decoder_layer(hp, p_prompt[l], None, conv0, s0, *w)
        hs, kn, vn, cn, sn = decoder_layer(hs, p_sample[l], (cache_swa_k[l], cache_swa_v[l]),
                                           state_conv[l], state_delta[l], *w)
        kp_l.append(kp); vp_l.append(vp); cp_l.append(cp); sp_l.append(sp.astype(state_delta.dtype))
        ks_l.append(kn); vs_l.append(vn); cs_l.append(cn); ss_l.append(sn.astype(state_delta.dtype))
    y_prompt = rmsnorm(hp, norm_final)
    y_sample = rmsnorm(hs, norm_final)
    return (y_prompt, y_sample,
            jnp.stack(kp_l), jnp.stack(vp_l), jnp.stack(cp_l), jnp.stack(sp_l),
            jnp.stack(ks_l), jnp.stack(vs_l), jnp.stack(cs_l), jnp.stack(ss_l))
```

```cpp
#include <hip/hip_runtime.h>
#include <hip/hip_cooperative_groups.h>
#include <cstdio>
#include <cstring>
namespace cg = cooperative_groups;

typedef unsigned short u16;
using bf16x8 = __attribute__((ext_vector_type(8))) short;
using f32x4 = __attribute__((ext_vector_type(4))) float;
using u32x4 = __attribute__((ext_vector_type(4))) unsigned int;
using f32x2 = __attribute__((ext_vector_type(2))) float;
#define SU 64.f
#define SV 16.f
typedef __bf16 bf16x2_hw __attribute__((ext_vector_type(2)));
__device__ __forceinline__ unsigned pack2(float a, float b) {
  f32x2 v = {a, b};
  return __builtin_bit_cast(unsigned, __builtin_convertvector(v, bf16x2_hw));
}
__device__ __forceinline__ u16 f2bf(float f) { return (u16)(pack2(f, 0.f) & 0xffffu); }

#define TP 32768
#define TS 1024
#define TT 33792
#define DM 1024
#define INW 2832
#define EPS 1e-6f

#define O_Y 0
#define O_KP 34603008
#define O_VP 34668544
#define O_CP 34734080
#define O_DP 34752512
#define O_KS 34883584
#define O_VS 36980736
#define O_CS 39077888
#define O_DS 39667712

struct P {
  const float *x_p, *x_s, *p_p, *p_s, *ck, *cv, *sconv, *sdelta, *norm_mix, *w_in, *conv_w, *sinks, *a_log,
      *dt_bias, *dn_norm, *w_out, *norm_ffn, *wq, *keys1, *keys2, *pu, *pv, *norm_ple, *ple_in, *ple_gate, *norm_final;
  float* out;
  char* ws;
  int ph_lo, ph_hi;
};
#define p_WinT ((u16*)(p.ws + 0ull))
#define p_WoutT ((u16*)(p.ws + 6029312ull))
#define p_WqT ((u16*)(p.ws + 8126464ull))
#define p_WgT ((u16*)(p.ws + 12320768ull))
#define p_WpT ((u16*)(p.ws + 14417920ull))
#define p_K1b ((u16*)(p.ws + 14942208ull))
#define p_K2b ((u16*)(p.ws + 15204352ull))
#define p_U8 ((unsigned char*)(p.ws + 15466496ull))
#define p_V8 ((unsigned char*)(p.ws + 32243712ull))
#define p_Pb ((u16*)(p.ws + 49020928ull))
#define p_Abf ((u16*)(p.ws + 66322432ull))
#define p_proj ((u16*)(p.ws + 135528448ull))
#define p_mix ((u16*)(p.ws + 326926336ull))
#define p_gl ((float*)(p.ws + 396132352ull))
#define p_ssq ((float*)(p.ws + 396148736ull))
#define p_bar ((unsigned*)(p.ws + 396283904ull))
#define p_Obuf ((float*)(p.ws + 396297728ull))
#define p_ssq2 ((float*)(p.ws + 463406592ull))
#define p_h16 ((u16*)(p.ws + 463541760ull))


__device__ __forceinline__ int tid_() { int t = threadIdx.x; asm volatile("" : "+v"(t)); return t; }
__device__ __forceinline__ float bf2f(u16 h) { return __uint_as_float(((unsigned)h) << 16); }

__device__ __forceinline__ float bflo(unsigned u) { return __uint_as_float(u << 16); }
__device__ __forceinline__ float bfhi(unsigned u) { return __uint_as_float(u & 0xffff0000u); }
union BF8 { bf16x8 v; uint4 q; unsigned u[4]; };
__device__ __forceinline__ bf16x8 pack8(float a0, float a1, float a2, float a3, float a4, float a5, float a6, float a7) {
  BF8 t; t.u[0] = pack2(a0, a1); t.u[1] = pack2(a2, a3); t.u[2] = pack2(a4, a5); t.u[3] = pack2(a6, a7); return t.v;
}
__device__ __forceinline__ bf16x8 pack8v(f32x4 a, f32x4 b) { return pack8(a[0], a[1], a[2], a[3], b[0], b[1], b[2], b[3]); }
__device__ __forceinline__ uint2 pack4v(f32x4 a) { uint2 r; r.x = pack2(a[0], a[1]); r.y = pack2(a[2], a[3]); return r; }
template <int CTRL>
__device__ __forceinline__ float dpp_f(float v) {
  return __int_as_float(__builtin_amdgcn_update_dpp(0, __float_as_int(v), CTRL, 0xf, 0xf, true));
}
#define DPP_XOR1 0xB1
#define DPP_XOR2 0x4E
#define DPP_HMIRROR 0x141
#define DPP_MIRROR 0x140
__device__ __forceinline__ float wave_sum(float v) {
  v += dpp_f<DPP_XOR1>(v);
  v += dpp_f<DPP_XOR2>(v);
  v += dpp_f<DPP_HMIRROR>(v);
  v += dpp_f<DPP_MIRROR>(v);
  float a = __int_as_float(__builtin_amdgcn_readlane(__float_as_int(v), 0));
  float b = __int_as_float(__builtin_amdgcn_readlane(__float_as_int(v), 16));
  float c = __int_as_float(__builtin_amdgcn_readlane(__float_as_int(v), 32));
  float d = __int_as_float(__builtin_amdgcn_readlane(__float_as_int(v), 48));
  return (a + b) + (c + d);
}
__device__ __forceinline__ float silu(float y) { return y / (1.f + __expf(-y)); }
__device__ __forceinline__ float sigmoidf(float y) { return 1.f / (1.f + __expf(-y)); }
__device__ __forceinline__ float softplusf(float x) { return x > 20.f ? x : log1pf(__expf(x)); }
__device__ __forceinline__ const float* xrow(const P& p, int t) {
  return t < TP ? p.x_p + (size_t)t * DM : p.x_s + (size_t)(t - TP) * DM;
}
__device__ __forceinline__ f32x4 mfma16(bf16x8 a, bf16x8 b, f32x4 c) { return __builtin_amdgcn_mfma_f32_16x16x32_bf16(a, b, c, 0, 0, 0); }

template <int NR, typename SRC>
__device__ __forceinline__ void rms_rows(SRC src, const float* __restrict__ g, u16* __restrict__ dst, int t0, int lane) {
  f32x4 v[NR][4];
#pragma unroll
  for (int r = 0; r < NR; ++r) {
    const float* sp = src(t0 + r);
#pragma unroll
    for (int i = 0; i < 4; ++i) v[r][i] = *(const f32x4*)(sp + i * 256 + lane * 4);
  }
  f32x4 gg[4];
#pragma unroll
  for (int i = 0; i < 4; ++i) gg[i] = *(const f32x4*)(g + i * 256 + lane * 4);
#pragma unroll
  for (int r = 0; r < NR; ++r) {
    float ss = 0.f;
#pragma unroll
    for (int i = 0; i < 4; ++i) ss += v[r][i][0] * v[r][i][0] + v[r][i][1] * v[r][i][1] + v[r][i][2] * v[r][i][2] + v[r][i][3] * v[r][i][3];
    ss = wave_sum(ss);
    const float rs = rsqrtf(ss * (1.f / 1024.f) + EPS);
#pragma unroll
    for (int i = 0; i < 4; ++i) {
      uint2 o; o.x = pack2(v[r][i][0] * rs * gg[i][0], v[r][i][1] * rs * gg[i][1]); o.y = pack2(v[r][i][2] * rs * gg[i][2], v[r][i][3] * rs * gg[i][3]);
      *(uint2*)(dst + (size_t)(t0 + r) * DM + i * 256 + lane * 4) = o;
    }
  }
}

__device__ __forceinline__ void conv_chunk4(const float* __restrict__ src, u16* __restrict__ dst, size_t base) {
  f32x4 a[4], b[4];
#pragma unroll
  for (int q = 0; q < 4; ++q) {
    size_t i = base + (size_t)q * 2048 + (size_t)tid_() * 8;
    a[q] = *(const f32x4*)(src + i); b[q] = *(const f32x4*)(src + i + 4);
  }
#pragma unroll
  for (int q = 0; q < 4; ++q) {
    size_t i = base + (size_t)q * 2048 + (size_t)tid_() * 8;
    BF8 t; t.u[0] = pack2(a[q][0], a[q][1]); t.u[1] = pack2(a[q][2], a[q][3]); t.u[2] = pack2(b[q][0], b[q][1]); t.u[3] = pack2(b[q][2], b[q][3]);
    *(uint4*)(dst + i) = t.q;
  }
}

__device__ __forceinline__ void conv_table_chunk4(const float* __restrict__ src, unsigned char* __restrict__ dst, size_t base, float scale) {
  f32x4 a[4], b[4];
#pragma unroll
  for (int q = 0; q < 4; ++q) {
    size_t i = base + (size_t)q * 2048 + (size_t)tid_() * 8;
    a[q] = *(const f32x4*)(src + i); b[q] = *(const f32x4*)(src + i + 4);
  }
#pragma unroll
  for (int q = 0; q < 4; ++q) {
    size_t i = base + (size_t)q * 2048 + (size_t)tid_() * 8;
    int w0 = 0, w1 = 0;
    w0 = __builtin_amdgcn_cvt_pk_fp8_f32(a[q][0] * scale, a[q][1] * scale, w0, false);
    w0 = __builtin_amdgcn_cvt_pk_fp8_f32(a[q][2] * scale, a[q][3] * scale, w0, true);
    w1 = __builtin_amdgcn_cvt_pk_fp8_f32(b[q][0] * scale, b[q][1] * scale, w1, false);
    w1 = __builtin_amdgcn_cvt_pk_fp8_f32(b[q][2] * scale, b[q][3] * scale, w1, true);
    size_t e = i >> 10; int col = (int)(i & 1023); int x = col >> 7;
    *(uint2*)(dst + ((size_t)x * 16384 + e) * 128 + (col & 127)) = make_uint2((unsigned)w0, (unsigned)w1);
  }
}

__device__ void ph_prep(const P& p, float* lds) {
  for (int i = blockIdx.x * 256 + tid_(); i < TT; i += gridDim.x * 256) { p_ssq[i] = 0.f; p_ssq2[i] = 0.f; }
  const int tid = tid_(), lane = tid & 63, wid = tid >> 6;
  const int NTR = 1824, NCV = 16 + 16 + 2048 + 2048 + 1024 + 32, NRM = TT / 16;
  for (int it = blockIdx.x; it < NTR + NCV + NRM; it += gridDim.x) {
    if (it < NTR) {
      const float* src; u16* dst; int K, N, ntn; int j = it;
      if (j < 736) { src = p.w_in; dst = p_WinT; K = 1024; N = INW; ntn = 46; }
      else if ((j -= 736) < 256) { src = p.w_out; dst = p_WoutT; K = 1024; N = 1024; ntn = 16; }
      else if ((j -= 256) < 512) { src = p.wq; dst = p_WqT; K = 1024; N = 2048; ntn = 32; }
      else if ((j -= 512) < 256) { src = p.ple_gate; dst = p_WgT; K = 1024; N = 1024; ntn = 16; }
      else { j -= 256; src = p.ple_in; dst = p_WpT; K = 256; N = 1024; ntn = 16; }
      int k0 = (j / ntn) * 64, n0 = (j % ntn) * 64;
      __syncthreads();
#pragma unroll
      for (int i = 0; i < 4; ++i) {
        int id = tid + i * 256, row = id >> 4, c4 = id & 15;
        int n = n0 + c4 * 4;
        float4 v = make_float4(0.f, 0.f, 0.f, 0.f);
        if (n < N) v = *(const float4*)(src + (size_t)(k0 + row) * N + n);
        float* d = lds + row * 65 + c4 * 4;
        d[0] = v.x; d[1] = v.y; d[2] = v.z; d[3] = v.w;
      }
      __syncthreads();
#pragma unroll
      for (int i = 0; i < 2; ++i) {
        int id = tid + i * 256, n = id >> 3, kc = id & 7;
        const float* s = lds + (kc * 8) * 65 + n;
        bf16x8 o = pack8(s[0], s[65], s[130], s[195], s[260], s[325], s[390], s[455]);
        *(bf16x8*)(dst + (size_t)(n0 + n) * K + k0 + kc * 8) = o;
      }
    } else if (it < NTR + NCV) {
      int j = it - NTR;
      if (j < 16) conv_chunk4(p.keys1, p_K1b, (size_t)j * 8192);
      else if ((j -= 16) < 16) conv_chunk4(p.keys2, p_K2b, (size_t)j * 8192);
      else if ((j -= 16) < 2048) conv_table_chunk4(p.pu, p_U8, (size_t)j * 8192, SU);
      else if ((j -= 2048) < 2048) conv_table_chunk4(p.pv, p_V8, (size_t)j * 8192, SV);
      else if ((j -= 2048) < 1024) conv_chunk4(p.p_p, p_Pb, (size_t)j * 8192);
      else { j -= 1024; conv_chunk4(p.p_s, p_Pb + (size_t)TP * 256, (size_t)j * 8192); }
    } else {
      int t0 = (it - NTR - NCV) * 16 + wid * 4;
      rms_rows<4>([&](int t) { return xrow(p, t); }, p.norm_mix, p_Abf, t0, lane);
    }
  }
}

#define GEMM_STAGE_B 16384
#define RAW_BARRIER() do { asm volatile("s_waitcnt lgkmcnt(0)" ::: "memory"); __builtin_amdgcn_s_barrier(); } while (0)
struct GemmOps { const u16 *a0, *a1, *b0, *b1; };
__device__ __forceinline__ GemmOps gemm_ops(const u16* A, int lda, const u16* B, int ldb) {
  const int lane = tid_() & 63, wid = tid_() >> 6, rr = lane >> 2, c = lane & 3;
  const int R0 = wid * 16 + rr, R1 = (wid + 4) * 16 + rr;
  GemmOps g;
  g.a0 = A + (size_t)R0 * lda + ((c ^ ((R0 >> 2) & 3)) << 3);
  g.a1 = A + (size_t)R1 * lda + ((c ^ ((R1 >> 2) & 3)) << 3);
  g.b0 = B + (size_t)R0 * ldb + ((c ^ ((R0 >> 2) & 3)) << 3);
  g.b1 = B + (size_t)R1 * ldb + ((c ^ ((R1 >> 2) & 3)) << 3);
  return g;
}
__device__ __forceinline__ void gemm_issue(const GemmOps& g, int kt, int buf, char* L) {
  const int wid = tid_() >> 6;
  char* sb = L + buf * GEMM_STAGE_B;
  __builtin_amdgcn_global_load_lds((const unsigned*)(g.a0 + kt * 32), (unsigned*)(sb + wid * 1024), 16, 0, 0);
  __builtin_amdgcn_global_load_lds((const unsigned*)(g.a1 + kt * 32), (unsigned*)(sb + (wid + 4) * 1024), 16, 0, 0);
  __builtin_amdgcn_global_load_lds((const unsigned*)(g.b0 + kt * 32), (unsigned*)(sb + 8192 + wid * 1024), 16, 0, 0);
  __builtin_amdgcn_global_load_lds((const unsigned*)(g.b1 + kt * 32), (unsigned*)(sb + 8192 + (wid + 4) * 1024), 16, 0, 0);
}
__device__ __forceinline__ void gemm_prologue(const GemmOps& g, u16* lds) {
  gemm_issue(g, 0, 0, (char*)lds); gemm_issue(g, 1, 1, (char*)lds);
}
__device__ __forceinline__ void gemm_main(f32x4 (&acc)[4][4], const GemmOps& g, int K, u16* lds) {
  const int tid = tid_(), lane = tid & 63, wid = tid >> 6;
  const int wm = wid >> 1, wn = wid & 1, fr = lane & 15, fq = lane >> 4;
  char* L = (char*)lds;
  int offA[4], offB[4];
#pragma unroll
  for (int i = 0; i < 4; ++i) {
    const int Ra = wm * 64 + i * 16 + fr, Rb = wn * 64 + i * 16 + fr;
    offA[i] = Ra * 64 + ((fq ^ ((Ra >> 2) & 3)) << 4);
    offB[i] = 8192 + Rb * 64 + ((fq ^ ((Rb >> 2) & 3)) << 4);
  }
  auto comp = [&](int buf) __attribute__((always_inline)) {
    const char* sb = L + buf * GEMM_STAGE_B;
    bf16x8 a[4], b[4];
#pragma unroll
    for (int i = 0; i < 4; ++i) a[i] = *(const bf16x8*)(sb + offA[i]);
#pragma unroll
    for (int j = 0; j < 4; ++j) b[j] = *(const bf16x8*)(sb + offB[j]);
#pragma unroll
    for (int i = 0; i < 4; ++i)
#pragma unroll
      for (int j = 0; j < 4; ++j) acc[i][j] = mfma16(a[i], b[j], acc[i][j]);
  };
  const int nk = K >> 5;
#define GEMM_STEP(J, BUF, NBUF) do { asm volatile("s_waitcnt vmcnt(4)" ::: "memory"); RAW_BARRIER(); \
    if ((J) + 2 < nk) gemm_issue(g, (J) + 2, NBUF, L); comp(BUF); } while (0)
  int j = 0;
  for (; j + 3 <= nk - 1; j += 3) {
    GEMM_STEP(j, 0, 2);
    GEMM_STEP(j + 1, 1, 0);
    GEMM_STEP(j + 2, 2, 1);
  }
  GEMM_STEP(j, 0, 2);
  asm volatile("s_waitcnt vmcnt(0)" ::: "memory");
  RAW_BARRIER();
  comp(1);
#undef GEMM_STEP
}

__device__ __forceinline__ void zero_acc(f32x4 (&acc)[4][4]) {
#pragma unroll
  for (int i = 0; i < 4; ++i)
#pragma unroll
    for (int j = 0; j < 4; ++j) acc[i][j] = f32x4{0.f, 0.f, 0.f, 0.f};
}
#define ZERO_ACC(acc) zero_acc(acc)

#define EPS_STRIDE 68
template <typename PRE, typename OUT>
__device__ __forceinline__ void gemm_epilogue(f32x4 (&acc)[4][4], u16* lds, PRE pre, OUT out) {
  const int lane = tid_() & 63, wid = tid_() >> 6, fr = lane & 15, fq = lane >> 4;
  float* W = (float*)lds + 8192 + wid * (16 * EPS_STRIDE);
#pragma unroll
  for (int i = 0; i < 4; ++i) {
#pragma unroll
    for (int j = 0; j < 4; ++j)
#pragma unroll
      for (int r = 0; r < 4; ++r) W[(fq * 4 + r) * EPS_STRIDE + j * 16 + fr] = pre(i, j, r, acc[i][j][r]);
#pragma unroll
    for (int q = 0; q < 4; ++q) {
      const int row = q * 4 + (lane >> 4), c4 = lane & 15;
      const f32x4 v = *(const f32x4*)(W + row * EPS_STRIDE + c4 * 4);
      out(i * 16 + row, c4, v);
    }
  }
}

__device__ __forceinline__ float row16_sum(float v) {
  v += dpp_f<DPP_XOR1>(v); v += dpp_f<DPP_XOR2>(v); v += dpp_f<DPP_HMIRROR>(v); v += dpp_f<DPP_MIRROR>(v);
  return v;
}

__device__ void ph_gemm1(const P& p, u16* lds) {
  const int wid = tid_() >> 6, wm = wid >> 1, wn = wid & 1;
  const int NT = 23, NTILES = 264 * NT;
  int it = blockIdx.x;
  if (it >= NTILES) return;
  auto ops = [&](int t) __attribute__((always_inline)) { return gemm_ops(p_Abf + (size_t)(t / NT) * 128 * DM, DM, p_WinT + (size_t)(t % NT) * 128 * DM, DM); };
  GemmOps g = ops(it);
  __syncthreads();
  gemm_prologue(g, lds);
  while (true) {
    const int mt = it / NT, nt = it % NT;
    f32x4 acc[4][4]; ZERO_ACC(acc);
    gemm_main(acc, g, DM, lds);
    const int itn = it + gridDim.x; const bool more = itn < NTILES;
    __syncthreads();
    if (more) { g = ops(itn); gemm_prologue(g, lds); }
    gemm_epilogue(acc, lds, [](int, int, int, float v) { return v; },
      [&](int rowl, int c4, f32x4 v) {
        const int m = mt * 128 + wm * 64 + rowl, n = nt * 128 + wn * 64 + c4 * 4;
        if (n < INW) *(uint2*)(p_proj + (size_t)m * INW + n) = pack4v(v);
      });
    if (!more) break;
    it = itn;
  }
}

__device__ void ph_gemm2(const P& p, u16* lds) {
  const int lane = tid_() & 63, wid = tid_() >> 6, wm = wid >> 1, wn = wid & 1;
  const int NT = 8, NTILES = 264 * NT;
  int it = blockIdx.x;
  if (it >= NTILES) return;
  auto ops = [&](int t) __attribute__((always_inline)) { return gemm_ops(p_mix + (size_t)(t / NT) * 128 * DM, DM, p_WoutT + (size_t)(t % NT) * 128 * DM, DM); };
  GemmOps g = ops(it);
  __syncthreads();
  gemm_prologue(g, lds);
  while (true) {
    const int mt = it / NT, nt = it % NT;
    f32x4 acc[4][4]; ZERO_ACC(acc);
    gemm_main(acc, g, DM, lds);
    const int itn = it + gridDim.x; const bool more = itn < NTILES;
    __syncthreads();
    if (more) { g = ops(itn); gemm_prologue(g, lds); }
    const f32x4 g4 = *(const f32x4*)(p.norm_ffn + nt * 128 + wn * 64 + (lane & 15) * 4);
    gemm_epilogue(acc, lds, [](int, int, int, float v) { return v; },
      [&](int rowl, int c4, f32x4 v) {
        const int m = mt * 128 + wm * 64 + rowl, n = nt * 128 + wn * 64 + c4 * 4;
        const f32x4 hv = *(const f32x4*)(xrow(p, m) + n) + v;
        *(uint2*)(p_h16 + (size_t)m * DM + n) = pack4v(hv);
        *(uint2*)(p_Abf + (size_t)m * DM + n) = pack4v(hv * g4);
        const float part = row16_sum(hv[0] * hv[0] + hv[1] * hv[1] + hv[2] * hv[2] + hv[3] * hv[3]);
        if (c4 == 0) atomicAdd(p_ssq2 + m, part);
      });
    if (!more) break;
    it = itn;
  }
}

__device__ void ph_gemm3(const P& p, u16* lds) {
  const int wid = tid_() >> 6, wm = wid >> 1, wn = wid & 1;
  const int NT = 16, NTILES = 264 * NT;
  u16* Qb = p_proj;
  int it = blockIdx.x;
  if (it >= NTILES) return;
  auto ops = [&](int t) __attribute__((always_inline)) { return gemm_ops(p_Abf + (size_t)(t / NT) * 128 * DM, DM, p_WqT + (size_t)(t % NT) * 128 * DM, DM); };
  GemmOps g = ops(it);
  __syncthreads();
  gemm_prologue(g, lds);
  while (true) {
    const int mt = it / NT, nt = it % NT;
    f32x4 acc[4][4]; ZERO_ACC(acc);
    gemm_main(acc, g, DM, lds);
    const int itn = it + gridDim.x; const bool more = itn < NTILES;
    __syncthreads();
    if (more) { g = ops(itn); gemm_prologue(g, lds); }
    gemm_epilogue(acc, lds, [](int, int, int, float v) { return v; },
      [&](int rowl, int c4, f32x4 v) {
        const int m = mt * 128 + wm * 64 + rowl, n = nt * 128 + wn * 64 + c4 * 4;
        const float rs = rsqrtf(p_ssq2[m] * (1.f / 1024.f) + EPS);
        *(uint2*)(Qb + (size_t)m * 2048 + n) = pack4v(v * rs);
      });
    if (!more) break;
    it = itn;
  }
}

__device__ void ph_gemm4(const P& p, u16* lds) {
  const int lane = tid_() & 63, wid = tid_() >> 6, wm = wid >> 1, wn = wid & 1, fq = lane >> 4;
  const int NT = 8, NTILES = 264 * NT;
  int it = blockIdx.x;
  if (it >= NTILES) return;
  auto opsP = [&](int t) __attribute__((always_inline)) { return gemm_ops(p_Pb + (size_t)(t / NT) * 128 * 256, 256, p_WpT + (size_t)(t % NT) * 128 * 256, 256); };
  auto opsG = [&](int t) __attribute__((always_inline)) { return gemm_ops(p_Abf + (size_t)(t / NT) * 128 * DM, DM, p_WgT + (size_t)(t % NT) * 128 * DM, DM); };
  GemmOps g = opsP(it);
  __syncthreads();
  gemm_prologue(g, lds);
  while (true) {
    const int mt = it / NT, nt = it % NT;
    f32x4 acc[4][4]; ZERO_ACC(acc);
    gemm_main(acc, g, 256, lds);
    __syncthreads();
    g = opsG(it);
    gemm_prologue(g, lds);
    uint2 pp[4][4];
#pragma unroll
    for (int i = 0; i < 4; ++i)
#pragma unroll
      for (int j = 0; j < 4; ++j) pp[i][j] = pack4v(acc[i][j]);
    ZERO_ACC(acc);
    gemm_main(acc, g, DM, lds);
    const int itn = it + gridDim.x; const bool more = itn < NTILES;
    __syncthreads();
    if (more) { g = opsP(itn); gemm_prologue(g, lds); }
    float rs[4][4];
#pragma unroll
    for (int i = 0; i < 4; ++i)
#pragma unroll
      for (int r = 0; r < 4; ++r) rs[i][r] = rsqrtf(p_ssq[mt * 128 + wm * 64 + i * 16 + fq * 4 + r] * (1.f / 1024.f) + EPS);
    gemm_epilogue(acc, lds,
      [&](int i, int j, int r, float v) {
        const unsigned gw = (r < 2) ? pp[i][j].x : pp[i][j].y;
        const float pv = (r & 1) ? bfhi(gw) : bflo(gw);
        return pv * sigmoidf(v * rs[i][r]);
      },
      [&](int rowl, int c4, f32x4 v) {
        const int m = mt * 128 + wm * 64 + rowl, n = nt * 128 + wn * 64 + c4 * 4;
        uint2* o = (uint2*)(p_h16 + (size_t)m * DM + n);
        const uint2 hb = *o;
        const f32x4 hn = f32x4{bflo(hb.x), bfhi(hb.x), bflo(hb.y), bfhi(hb.y)} + v;
        *o = pack4v(hn);
      });
    if (!more) break;
    it = itn;
  }
}

#define LS 68
__device__ __forceinline__ bf16x8 ldsfrag8(const float* buf, int row, int col) {
  const float4 a = *(const float4*)(buf + row * LS + col), b = *(const float4*)(buf + row * LS + col + 4);
  return pack8(a.x, a.y, a.z, a.w, b.x, b.y, b.z, b.w);
}

__device__ void ph_dnpre(const P& p, float* lds) {
  const int tid = tid_(), lane = tid & 63, w = tid >> 6, fr = lane & 15, fq = lane >> 4;
  float* B0 = lds; float* B1 = lds + 64 * LS; float* B2 = lds + 2 * 64 * LS;
  float* sG = lds + 3 * 64 * LS;
  float* sBeta = sG + 64;
  float* sEG = sG + 128;
  u16* DNW = (u16*)p.out;
  u16* DNQH = DNW + (size_t)4096 * 4096;
  u16* DNQK = DNQH + (size_t)4096 * 4096;
  u16* DNKT = DNQK + (size_t)4096 * 4096;
  float* Ubuf = (float*)p_Abf;
  u16 xn[3][19]; u16 arn = 0, brn = 0;
  auto load_raw = [&](int chunk) __attribute__((always_inline)) {
    const int n = chunk & 127, h = (chunk >> 7) & 7, b = chunk >> 10;
    const size_t tok0 = (size_t)b * 8192 + n * 64;
    const bool has_prev = (n * 64 + w * 16) >= 3;
#pragma unroll
    for (int arr = 0; arr < 3; ++arr) {
      const u16* src = p_proj + 768 + arr * 512 + h * 64 + lane;
#pragma unroll
      for (int i = 0; i < 19; ++i) {
        const long row = (long)tok0 + w * 16 + i - 3;
        xn[arr][i] = (i >= 3 || has_prev) ? src[row * INW] : (u16)0;
      }
    }
    if (w == 0) {
      arn = p_proj[(tok0 + lane) * INW + 2816 + h];
      brn = p_proj[(tok0 + lane) * INW + 2824 + h];
    }
  };
  if ((int)blockIdx.x < 4096) load_raw(blockIdx.x);
  for (int chunk = blockIdx.x; chunk < 4096; chunk += gridDim.x) {
    const int n = chunk & 127, h = (chunk >> 7) & 7, b = chunk >> 10;
    const size_t tok0 = (size_t)b * 8192 + n * 64;
    __syncthreads();
    {
      u16 xr[3][19];
#pragma unroll
      for (int arr = 0; arr < 3; ++arr)
#pragma unroll
        for (int i = 0; i < 19; ++i) xr[arr][i] = xn[arr][i];
      const float ar_raw = bf2f(arn), br_raw = bf2f(brn);
      if (chunk + (int)gridDim.x < 4096) load_raw(chunk + gridDim.x);
#pragma unroll
      for (int arr = 0; arr < 3; ++arr) {
        const int ch = arr * 512 + h * 64 + lane;
        const float w0 = p.conv_w[ch], w1 = p.conv_w[1536 + ch], w2 = p.conv_w[3072 + ch], w3 = p.conv_w[4608 + ch];
        float* dst = arr == 0 ? B0 : (arr == 1 ? B1 : B2);
#pragma unroll
        for (int i = 0; i < 16; ++i) {
          float y = silu(w0 * bf2f(xr[arr][i]) + w1 * bf2f(xr[arr][i + 1]) + w2 * bf2f(xr[arr][i + 2]) + w3 * bf2f(xr[arr][i + 3]));
          if (arr < 2) {
            float ss = wave_sum(y * y);
            y *= rsqrtf(ss + EPS) * (arr == 0 ? 0.125f : 1.f);
          }
          dst[(w * 16 + i) * LS + lane] = y;
        }
      }
      if (w == 0) {
        float g = -__expf(p.a_log[h]) * softplusf(ar_raw + p.dt_bias[h]);
#pragma unroll
        for (int o = 1; o < 64; o <<= 1) {
          float t = __shfl_up(g, o);
          if (lane >= o) g += t;
        }
        sG[lane] = g;
        sBeta[lane] = sigmoidf(br_raw);
        sEG[lane] = __expf(g);
      }
    }
    __syncthreads();
    const float glast = sG[63];
    f32x4 kk[4];
    {
      bf16x8 qB[2], kB[2];
#pragma unroll
      for (int ks = 0; ks < 2; ++ks) { qB[ks] = ldsfrag8(B0, w * 16 + fr, ks * 32 + fq * 8); kB[ks] = ldsfrag8(B1, w * 16 + fr, ks * 32 + fq * 8); }
      f32x4 qk[4];
      const int ci = w * 16 + fr;
      const float Gc = sG[ci];
#pragma unroll
      for (int mt = 0; mt < 4; ++mt) {
        bf16x8 kA0 = ldsfrag8(B1, mt * 16 + fr, fq * 8), kA1 = ldsfrag8(B1, mt * 16 + fr, 32 + fq * 8);
        f32x4 z = {0.f, 0.f, 0.f, 0.f};
        qk[mt] = mfma16(kA0, qB[0], z); qk[mt] = mfma16(kA1, qB[1], qk[mt]);
        kk[mt] = mfma16(kA0, kB[0], z); kk[mt] = mfma16(kA1, kB[1], kk[mt]);
#pragma unroll
        for (int r = 0; r < 4; ++r) {
          int rw = mt * 16 + fq * 4 + r;
          float Gr = sG[rw];
          qk[mt][r] = (ci >= rw) ? qk[mt][r] * __expf(Gc - Gr) : 0.f;
          kk[mt][r] = (rw > ci) ? kk[mt][r] * sBeta[rw] * __expf(Gr - Gc) : 0.f;
        }
      }
#pragma unroll
      for (int kb = 0; kb < 2; ++kb)
        *(bf16x8*)(DNQK + (size_t)chunk * 4096 + ((w * 2 + kb) * 64 + lane) * 8) = pack8v(qk[2 * kb], qk[2 * kb + 1]);
      {
        const float eg = __expf(sG[w * 16 + fr]);
#pragma unroll
        for (int kb = 0; kb < 2; ++kb) {
          const float4 a = *(const float4*)(B0 + (w * 16 + fr) * LS + kb * 32 + fq * 4);
          const float4 c = *(const float4*)(B0 + (w * 16 + fr) * LS + kb * 32 + 16 + fq * 4);
          *(bf16x8*)(DNQH + (size_t)chunk * 4096 + ((w * 2 + kb) * 64 + lane) * 8) =
              pack8(a.x * eg, a.y * eg, a.z * eg, a.w * eg, c.x * eg, c.y * eg, c.z * eg, c.w * eg);
        }
      }
      {
        const int d = w * 16 + fr;
#pragma unroll
        for (int kb = 0; kb < 2; ++kb) {
          float v[8];
#pragma unroll
          for (int e = 0; e < 8; ++e) {
            int tk = kb * 32 + (e >> 2) * 16 + fq * 4 + (e & 3);
            v[e] = B1[tk * LS + d] * __expf(glast - sG[tk]);
          }
          *(bf16x8*)(DNKT + (size_t)chunk * 4096 + ((w * 2 + kb) * 64 + lane) * 8) = pack8(v[0], v[1], v[2], v[3], v[4], v[5], v[6], v[7]);
        }
      }
    }
    __syncthreads();
#pragma unroll
    for (int mt = 0; mt < 4; ++mt)
#pragma unroll
      for (int r = 0; r < 4; ++r) {
        const int j = w * 16 + fr;
        B0[(j & 1) * 2048 + (mt * 16 + fq * 4 + r) * 32 + (j >> 1)] = kk[mt][r];
      }
    __syncthreads();
    {
      const int c = tid >> 1, par = tid & 1;
      float xe[32];
      float* col = c < 64 ? (B2 + c) : (B1 + c - 64);
      const float* Lp = B0 + par * 2048;
#pragma unroll
      for (int i = 0; i < 64; ++i) {
        float sc = sBeta[i];
        if (c >= 64) sc *= sEG[i];
        const float rhs = col[i * LS] * sc;
        float a0 = 0.f, a1 = 0.f;
#pragma unroll
        for (int jj = 0; 2 * jj + 1 < i; ++jj) {
          const float l = Lp[i * 32 + jj];
          if (jj & 1) a1 += l * xe[jj]; else a0 += l * xe[jj];
        }
        if (i & 1) {
          const float l = B0[i * 32 + (i >> 1)];
          a0 += (par == 0) ? l * xe[i >> 1] : 0.f;
        }
        float acc = a0 + a1;
        acc += dpp_f<DPP_XOR1>(acc);
        const float xi = rhs - acc;
        if ((i & 1) == 0) xe[i >> 1] = xi;
        else xe[i >> 1] = (par == 1) ? xi : xe[i >> 1];
      }
#pragma unroll
      for (int jj = 0; jj < 32; ++jj) col[(2 * jj + par) * LS] = xe[jj];
    }
    __syncthreads();
#pragma unroll
    for (int kb = 0; kb < 2; ++kb) {
      const float4 a = *(const float4*)(B1 + (w * 16 + fr) * LS + kb * 32 + fq * 4);
      const float4 c = *(const float4*)(B1 + (w * 16 + fr) * LS + kb * 32 + 16 + fq * 4);
      *(bf16x8*)(DNW + (size_t)chunk * 4096 + ((w * 2 + kb) * 64 + lane) * 8) = pack8(a.x, a.y, a.z, a.w, c.x, c.y, c.z, c.w);
    }
#pragma unroll
    for (int nt = 0; nt < 4; ++nt) {
      f32x4 u;
#pragma unroll
      for (int r = 0; r < 4; ++r) u[r] = B2[(w * 16 + fq * 4 + r) * LS + nt * 16 + fr];
      *(f32x4*)(Ubuf + (size_t)chunk * 4096 + ((w * 4 + nt) * 64 + lane) * 4) = u;
    }
    if (tid == 0) p_gl[chunk] = __expf(glast);
  }
}

struct ScanCtx {
  const u16 *DNW, *DNQH, *DNQK, *DNKT;
  const float* Ubuf; float* Obuf; const float* glp; u16* Vbuf;
  int seq, w, lane;
};
__device__ __forceinline__ void scan_load(const ScanCtx& c, int n, bf16x8 (&W_)[2], bf16x8 (&QH_)[2], bf16x8 (&QK_)[2],
                                          bf16x8 (&KT_)[2], f32x4 (&U_)[4], float& g_) {
  n = n < 128 ? n : 127;
  const size_t cb = (size_t)(c.seq * 128 + n) * 4096;
#pragma unroll
  for (int kb = 0; kb < 2; ++kb) {
    const size_t o = cb + ((c.w * 2 + kb) * 64 + c.lane) * 8;
    W_[kb] = *(const bf16x8*)(c.DNW + o); QH_[kb] = *(const bf16x8*)(c.DNQH + o); QK_[kb] = *(const bf16x8*)(c.DNQK + o); KT_[kb] = *(const bf16x8*)(c.DNKT + o);
  }
#pragma unroll
  for (int nt = 0; nt < 4; ++nt) U_[nt] = *(const f32x4*)(c.Ubuf + cb + ((c.w * 4 + nt) * 64 + c.lane) * 4);
  g_ = c.glp[c.seq * 128 + n];
}
__device__ __forceinline__ void scan_step(const ScanCtx& c, int n, const u16* Sc, u16* Sn, f32x4 (&S)[4], bf16x8 (&W_)[2],
                                          bf16x8 (&QH_)[2], bf16x8 (&QK_)[2], bf16x8 (&KT_)[2], f32x4 (&U_)[4], float& g_,
                                          unsigned (&tr)[7]) {
  const int w = c.w, lane = c.lane;
  const size_t cb = (size_t)(c.seq * 128 + n) * 4096;
  bf16x8 Sf[2][4];
#pragma unroll
  for (int kb = 0; kb < 2; ++kb)
#pragma unroll
    for (int nt = 0; nt < 4; ++nt) Sf[kb][nt] = *(const bf16x8*)(Sc + ((kb * 4 + nt) * 64 + lane) * 8);
#pragma unroll
  for (int nt = 0; nt < 4; ++nt) {
    f32x4 a = {0.f, 0.f, 0.f, 0.f};
    a = mfma16(W_[0], Sf[0][nt], a); a = mfma16(W_[1], Sf[1][nt], a);
    f32x4 vn = U_[nt] - a;
    *(uint2*)(c.Vbuf + (((w >> 1) * 4 + nt) * 64 + lane) * 8 + (w & 1) * 4) = pack4v(vn);
  }
  __syncthreads();
  bf16x8 Vf[2][4];
#pragma unroll
  for (int kb = 0; kb < 2; ++kb)
#pragma unroll
    for (int nt = 0; nt < 4; ++nt) Vf[kb][nt] = *(const bf16x8*)(c.Vbuf + ((kb * 4 + nt) * 64 + lane) * 8);
  const float glc = g_;
#pragma unroll
  for (int nt = 0; nt < 4; ++nt) {
    f32x4 o = {0.f, 0.f, 0.f, 0.f};
    o = mfma16(QH_[0], Sf[0][nt], o); o = mfma16(QH_[1], Sf[1][nt], o);
    o = mfma16(QK_[0], Vf[0][nt], o); o = mfma16(QK_[1], Vf[1][nt], o);
    *(f32x4*)(c.Obuf + cb + ((w * 4 + nt) * 64 + lane) * 4) = o;
    f32x4 sv = S[nt] * glc;
    sv = mfma16(KT_[0], Vf[0][nt], sv); sv = mfma16(KT_[1], Vf[1][nt], sv);
    S[nt] = sv;
    *(uint2*)(Sn + (((w >> 1) * 4 + nt) * 64 + lane) * 8 + (w & 1) * 4) = pack4v(sv);
  }
  __builtin_amdgcn_sched_barrier(0);
  scan_load(c, n + 2, W_, QH_, QK_, KT_, U_, g_);
  {
    tr[0] ^= tr[1] ^ tr[4];
    tr[1] = tr[2]; tr[4] = tr[5]; tr[2] = tr[3]; tr[5] = tr[6];
    const size_t pb = (size_t)(c.seq * 128 + (n + 5 < 128 ? n + 5 : 127)) * 4096;
    const u16* arr4 = (lane >> 4) == 0 ? c.DNW : ((lane >> 4) == 1 ? c.DNQH : ((lane >> 4) == 2 ? c.DNQK : c.DNKT));
    tr[3] = *(const unsigned*)(arr4 + pb + w * 1024 + (lane & 15) * 64);
    tr[6] = *(const unsigned*)(c.Ubuf + pb + w * 1024 + (lane & 31) * 32);
  }
  __syncthreads();
}

__device__ void scan_seq(const P& p, int seq, u16* lds) {
  const int tid = tid_(), lane = tid & 63, w = tid >> 6, fr = lane & 15, fq = lane >> 4;
  u16* Sb0 = lds; u16* Sb1 = lds + 4096;
  ScanCtx c;
  c.DNW = (const u16*)p.out;
  c.DNQH = c.DNW + (size_t)4096 * 4096;
  c.DNQK = c.DNQH + (size_t)4096 * 4096;
  c.DNKT = c.DNQK + (size_t)4096 * 4096;
  c.Ubuf = (const float*)p_Abf; c.Obuf = p_Obuf; c.glp = p_gl; c.Vbuf = lds + 8192;
  c.seq = seq; c.w = w; c.lane = lane;
  __syncthreads();
  for (int i = tid; i < 4096 / 2; i += 256) ((unsigned*)Sb0)[i] = 0u;
  f32x4 S[4];
#pragma unroll
  for (int nt = 0; nt < 4; ++nt) S[nt] = f32x4{0.f, 0.f, 0.f, 0.f};
  bf16x8 Wa[2], QHa[2], QKa[2], KTa[2]; f32x4 Ua[4]; float ga;
  bf16x8 Wb[2], QHb[2], QKb[2], KTb[2]; f32x4 Ub[4]; float gb;
  unsigned tr[7] = {0u, 0u, 0u, 0u, 0u, 0u, 0u};
  scan_load(c, 0, Wa, QHa, QKa, KTa, Ua, ga);
  scan_load(c, 1, Wb, QHb, QKb, KTb, Ub, gb);
  __syncthreads();
#pragma unroll 1
  for (int n = 0; n < 128; n += 2) {
    scan_step(c, n, Sb0, Sb1, S, Wa, QHa, QKa, KTa, Ua, ga, tr);
    scan_step(c, n + 1, Sb1, Sb0, S, Wb, QHb, QKb, KTb, Ub, gb, tr);
  }
  if ((tr[0] ^ tr[1] ^ tr[2] ^ tr[3] ^ tr[4] ^ tr[5] ^ tr[6]) == 0x9e3779b9u && seq == 4097) p_gl[0] = 0.f;
#pragma unroll
  for (int nt = 0; nt < 4; ++nt)
#pragma unroll
    for (int r = 0; r < 4; ++r) p.out[O_DP + ((size_t)seq * 64 + w * 16 + fq * 4 + r) * 64 + nt * 16 + fr] = S[nt][r];
}

#define VS 280
template <int NQ, typename KL>
__device__ __forceinline__ void attn_core(const bf16x8 (&qf)[NQ][2], KL kload, const u16* vT, const float (&slope)[NQ],
                                          const float (&sink)[NQ], const int (&ql)[NQ], int jmin, f32x4 (&o)[4][NQ]) {
  const int lane = tid_() & 63, fr = lane & 15, fq = lane >> 4;
  f32x4 s[10][NQ];
#pragma unroll
  for (int mt = 0; mt < 10; ++mt) {
    bf16x8 k0 = kload(mt, 0), k1 = kload(mt, 1);
#pragma unroll
    for (int nq = 0; nq < NQ; ++nq) {
      f32x4 z = {0.f, 0.f, 0.f, 0.f};
      z = mfma16(k0, qf[nq][0], z);
      s[mt][nq] = mfma16(k1, qf[nq][1], z);
    }
  }
#pragma unroll
  for (int nq = 0; nq < NQ; ++nq) {
    float m = sink[nq];
#pragma unroll
    for (int mt = 0; mt < 10; ++mt)
#pragma unroll
      for (int r = 0; r < 4; ++r) {
        int jl = mt * 16 + fq * 4 + r;
        bool valid = (jl >= ql[nq]) && (jl <= ql[nq] + 128) && (jl >= jmin);
        float dist = (float)(128 + ql[nq] - jl);
        float v = valid ? s[mt][nq][r] * 0.125f - slope[nq] * dist : -1e30f;
        s[mt][nq][r] = v;
        m = fmaxf(m, v);
      }
    m = fmaxf(m, __shfl_xor(m, 16)); m = fmaxf(m, __shfl_xor(m, 32));
    float sum = 0.f;
#pragma unroll
    for (int mt = 0; mt < 10; ++mt)
#pragma unroll
      for (int r = 0; r < 4; ++r) { float e = __expf(s[mt][nq][r] - m); s[mt][nq][r] = e; sum += e; }
    sum += __shfl_xor(sum, 16); sum += __shfl_xor(sum, 32);
    float inv = 1.f / (sum + __expf(sink[nq] - m));
#pragma unroll
    for (int mt = 0; mt < 10; ++mt) s[mt][nq] = s[mt][nq] * inv;
  }
#pragma unroll
  for (int mt = 0; mt < 4; ++mt)
#pragma unroll
    for (int nq = 0; nq < NQ; ++nq) o[mt][nq] = f32x4{0.f, 0.f, 0.f, 0.f};
#pragma unroll
  for (int kb = 0; kb < 5; ++kb) {
    bf16x8 pf[NQ];
#pragma unroll
    for (int nq = 0; nq < NQ; ++nq) pf[nq] = pack8v(s[2 * kb][nq], s[2 * kb + 1][nq]);
#pragma unroll
    for (int mt = 0; mt < 4; ++mt) {
      const u16* vr = vT + (mt * 16 + fr) * VS + kb * 32 + fq * 4;
      BF8 vf; uint2 a = *(const uint2*)vr, c = *(const uint2*)(vr + 16);
      vf.u[0] = a.x; vf.u[1] = a.y; vf.u[2] = c.x; vf.u[3] = c.y;
#pragma unroll
      for (int nq = 0; nq < NQ; ++nq) o[mt][nq] = mfma16(vf.v, pf[nq], o[mt][nq]);
    }
  }
}

__device__ void attn_prompt_item(const P& p, int item, u16* vT) {
  const int tid = tid_(), lane = tid & 63, w = tid >> 6, fr = lane & 15, fq = lane >> 4;
  const int head = item & 7, n = (item >> 3) & 63, b = item >> 9, kvh = head >> 2;
  __syncthreads();
#pragma unroll
  for (int i = 0; i < 8; ++i) {
    int id = tid + i * 256, j = id >> 3, c = id & 7;
    int pos = (n - 1) * 128 + j;
    BF8 t; t.q = make_uint4(0, 0, 0, 0);
    if (pos >= 0) t.q = *(const uint4*)(p_proj + ((size_t)b * 8192 + pos) * INW + 640 + kvh * 64 + c * 8);
#pragma unroll
    for (int e = 0; e < 8; ++e) vT[(c * 8 + e) * VS + j] = (u16)(t.u[e >> 1] >> ((e & 1) * 16));
  }
  if (tid < 64) {
#pragma unroll
    for (int e = 0; e < 24; ++e) vT[tid * VS + 256 + e] = 0;
  }
  __syncthreads();
#pragma unroll 1
  for (int nq = 0; nq < 2; ++nq) {
    const int i0 = w * 32 + nq * 16;
    const size_t tokb = (size_t)b * 8192 + n * 128 + i0;
    bf16x8 qf[1][2];
#pragma unroll
    for (int ks = 0; ks < 2; ++ks) qf[0][ks] = *(const bf16x8*)(p_proj + (tokb + fr) * INW + head * 64 + ks * 32 + fq * 8);
    auto kload = [&](int mt, int ks) -> bf16x8 {
      int pos = (n - 1) * 128 + i0 + mt * 16 + fr;
      pos = pos < 0 ? 0 : pos;
      pos = pos > n * 128 + 127 ? n * 128 + 127 : pos;
      return *(const bf16x8*)(p_proj + ((size_t)b * 8192 + pos) * INW + 512 + kvh * 64 + ks * 32 + fq * 8);
    };
    float slope[1], sink[1]; int ql[1];
    slope[0] = exp2f(-(float)(head + 1));
    sink[0] = p.sinks[head];
    ql[0] = fr;
    const int jmin = (n == 0) ? 128 - i0 : 0;
    f32x4 o[4][1];
    attn_core<1>(qf, kload, vT + i0, slope, sink, ql, jmin, o);
#pragma unroll
    for (int mt = 0; mt < 4; ++mt)
      *(uint2*)(p_mix + (tokb + fr) * DM + head * 64 + mt * 16 + fq * 4) = pack4v(o[mt][0]);
  }
}

__device__ void attn_sample_item(const P& p, int item, u16* vT) {
  const int tid = tid_(), lane = tid & 63, w = tid >> 6, fr = lane & 15, fq = lane >> 4;
  const int kvh = item & 1, b = item >> 1;
  __syncthreads();
  for (int id = tid; id < 168 * 8; id += 256) {
    int j = id >> 3, c = id & 7;
    BF8 t; t.q = make_uint4(0, 0, 0, 0);
    if (j < 128) {
      const float* s = p.cv + (((size_t)b * 128 + j) * 2 + kvh) * 64 + c * 8;
      float4 a = *(const float4*)s, d = *(const float4*)(s + 4);
      t.u[0] = pack2(a.x, a.y); t.u[1] = pack2(a.z, a.w); t.u[2] = pack2(d.x, d.y); t.u[3] = pack2(d.z, d.w);
    } else if (j < 136) {
      t.q = *(const uint4*)(p_proj + ((size_t)TP + b * 8 + (j - 128)) * INW + 640 + kvh * 64 + c * 8);
    }
#pragma unroll
    for (int e = 0; e < 8; ++e) vT[(c * 8 + e) * VS + j] = (u16)(t.u[e >> 1] >> ((e & 1) * 16));
  }
  __syncthreads();
  if (w < 2) {
    const int r = w * 16 + fr, hq = kvh * 4 + (r >> 3), ti = r & 7;
    const size_t tok = (size_t)TP + b * 8 + ti;
    bf16x8 qf[1][2];
#pragma unroll
    for (int ks = 0; ks < 2; ++ks) qf[0][ks] = *(const bf16x8*)(p_proj + tok * INW + hq * 64 + ks * 32 + fq * 8);
    auto kload = [&](int mt, int ks) -> bf16x8 {
      int jl = mt * 16 + fr;
      if (jl < 128) {
        const float* s = p.ck + (((size_t)b * 128 + jl) * 2 + kvh) * 64 + ks * 32 + fq * 8;
        float4 a = *(const float4*)s, d = *(const float4*)(s + 4);
        return pack8(a.x, a.y, a.z, a.w, d.x, d.y, d.z, d.w);
      }
      int t = jl - 128; t = t > 7 ? 7 : t;
      return *(const bf16x8*)(p_proj + ((size_t)TP + b * 8 + t) * INW + 512 + kvh * 64 + ks * 32 + fq * 8);
    };
    float slope[1], sink[1]; int ql[1];
    slope[0] = exp2f(-(float)(hq + 1)); sink[0] = p.sinks[hq]; ql[0] = ti;
    f32x4 o[4][1];
    attn_core<1>(qf, kload, vT, slope, sink, ql, 0, o);
#pragma unroll
    for (int mt = 0; mt < 4; ++mt) *(uint2*)(p_mix + tok * DM + hq * 64 + mt * 16 + fq * 4) = pack4v(o[mt][0]);
  }
}

__device__ void dn_sample_wave(const P& p, int bh) {
  const int lane = tid_() & 63;
  const int h = bh & 7, b = bh >> 3;
  float cw[3][4], xs[3][3];
#pragma unroll
  for (int arr = 0; arr < 3; ++arr) {
    const int ch = arr * 512 + h * 64 + lane;
#pragma unroll
    for (int j = 0; j < 4; ++j) cw[arr][j] = p.conv_w[j * 1536 + ch];
#pragma unroll
    for (int j = 0; j < 3; ++j) xs[arr][j] = p.sconv[((size_t)b * 3 + j) * 1536 + ch];
  }
  float S[64];
  const float* s0 = p.sdelta + (size_t)bh * 4096 + lane;
#pragma unroll
  for (int d = 0; d < 64; ++d) S[d] = s0[d * 64];
  const float eA = __expf(p.a_log[h]), dtb = p.dt_bias[h], gn = p.dn_norm[lane];
  u16 nx[3], nar, nbr, nz;
  {
    const size_t tok = (size_t)TP + b * 8;
#pragma unroll
    for (int arr = 0; arr < 3; ++arr) nx[arr] = p_proj[tok * INW + 768 + arr * 512 + h * 64 + lane];
    nar = p_proj[tok * INW + 2816 + h]; nbr = p_proj[tok * INW + 2824 + h]; nz = p_proj[tok * INW + 2304 + h * 64 + lane];
  }
#pragma unroll 1
  for (int t = 0; t < 8; ++t) {
    const size_t tok = (size_t)TP + b * 8 + t;
    const u16 cx0 = nx[0], cx1 = nx[1], cx2 = nx[2], car = nar, cbr = nbr, cz = nz;
    {
      const size_t tn = (size_t)TP + b * 8 + (t < 7 ? t + 1 : 7);
#pragma unroll
      for (int arr = 0; arr < 3; ++arr) nx[arr] = p_proj[tn * INW + 768 + arr * 512 + h * 64 + lane];
      nar = p_proj[tn * INW + 2816 + h]; nbr = p_proj[tn * INW + 2824 + h]; nz = p_proj[tn * INW + 2304 + h * 64 + lane];
    }
    float y[3];
#pragma unroll
    for (int arr = 0; arr < 3; ++arr) {
      float x3 = bf2f(arr == 0 ? cx0 : (arr == 1 ? cx1 : cx2));
      y[arr] = silu(cw[arr][0] * xs[arr][0] + cw[arr][1] * xs[arr][1] + cw[arr][2] * xs[arr][2] + cw[arr][3] * x3);
      xs[arr][0] = xs[arr][1]; xs[arr][1] = xs[arr][2]; xs[arr][2] = x3;
    }
    const float qv = y[0] * rsqrtf(wave_sum(y[0] * y[0]) + EPS) * 0.125f;
    const float kv = y[1] * rsqrtf(wave_sum(y[1] * y[1]) + EPS);
    const float vv = y[2];
    float ar = bf2f(car), br = bf2f(cbr);
    float a = __expf(-eA * softplusf(ar + dtb));
    float beta = sigmoidf(br);
    float kS = 0.f;
#pragma unroll
    for (int d = 0; d < 64; ++d) kS += __int_as_float(__builtin_amdgcn_readlane(__float_as_int(kv), d)) * S[d];
    float vn = beta * (vv - a * kS);
    float o = 0.f;
#pragma unroll
    for (int d = 0; d < 64; ++d) {
      float kd = __int_as_float(__builtin_amdgcn_readlane(__float_as_int(kv), d));
      float qd = __int_as_float(__builtin_amdgcn_readlane(__float_as_int(qv), d));
      S[d] = a * S[d] + kd * vn;
      o += qd * S[d];
    }
    float ss = wave_sum(o * o);
    float rs = rsqrtf(ss * (1.f / 64.f) + EPS);
    float z = bf2f(cz);
    p_mix[tok * DM + 512 + h * 64 + lane] = f2bf(o * rs * gn * silu(z));
  }
  float* so = p.out + O_DS + (size_t)bh * 4096 + lane;
#pragma unroll
  for (int d = 0; d < 64; ++d) so[d * 64] = S[d];
}

__device__ void copy_item(const P& p, int item) {
  int e = item * 2048 + tid_();
#pragma unroll
  for (int k = 0; k < 8; ++k, e += 256) {
    int i = e;
    if (i < 131072) {
      int which = i >> 16; i &= 65535;
      int d = i & 63, kvh = (i >> 6) & 1, wpos = (i >> 7) & 127, b = i >> 14;
      float v = bf2f(p_proj[((size_t)b * 8192 + 8064 + wpos) * INW + 512 + which * 128 + kvh * 64 + d]);
      p.out[(which ? O_VP : O_KP) + i] = v;
    } else if ((i -= 131072) < 18432) {
      int c = i % 1536, j = (i / 1536) % 3, b = i / 4608;
      p.out[O_CP + i] = bf2f(p_proj[((size_t)b * 8192 + 8189 + j) * INW + 768 + c]);
    } else if ((i -= 18432) < 4194304) {
      int which = i >> 21; i &= 2097151;
      int d = i & 63, kvh = (i >> 6) & 1, wpos = (i >> 7) & 127, b = i >> 14;
      float v;
      if (wpos < 120) v = (which ? p.cv : p.ck)[(((size_t)b * 128 + wpos + 8) * 2 + kvh) * 64 + d];
      else v = bf2f(p_proj[((size_t)TP + b * 8 + wpos - 120) * INW + 512 + which * 128 + kvh * 64 + d]);
      p.out[(which ? O_VS : O_KS) + i] = v;
    } else {
      i -= 4194304;
      int c = i % 1536, j = (i / 1536) % 3, b = i / 4608;
      p.out[O_CS + i] = bf2f(p_proj[((size_t)TP + b * 8 + 5 + j) * INW + 768 + c]);
    }
  }
}

__device__ void ph_mixer(const P& p, u16* lds) {
  const int NSCAN = 32;
#ifndef MIXMASK
#define MIXMASK 31
#endif
  if ((int)blockIdx.x < NSCAN) { if (MIXMASK & 1) scan_seq(p, blockIdx.x, lds); return; }
  const int NA = 2048, NSA = 256, NSD = 256, NCP = 2409;
  const int st = gridDim.x - NSCAN, b0 = blockIdx.x - NSCAN;
  auto first = [&](int off) { int f = b0 - (off % st); return f < 0 ? f + st : f; };
  if (MIXMASK & 8) for (int it = first(0); it < NSD; it += st) dn_sample_wave(p, it * 4 + (tid_() >> 6));
  if (MIXMASK & 4) for (int it = first(224); it < NSA; it += st) attn_sample_item(p, it, lds);
  if (MIXMASK & 2) for (int it = first(288); it < NA; it += st) attn_prompt_item(p, it, lds);
  if (MIXMASK & 16) for (int it = first(256); it < NCP; it += st) copy_item(p, it);
}

__device__ void ph_gatenorm(const P& p) {
  const int lane = tid_() & 63, w = tid_() >> 6, fr = lane & 15, fq = lane >> 4;
  const float* Ubuf = (const float*)p_Obuf;
  for (int chunk = blockIdx.x; chunk < 4096; chunk += gridDim.x) {
    const int n = chunk & 127, h = (chunk >> 7) & 7, b = chunk >> 10;
    f32x4 o[4];
    float ss[4] = {0.f, 0.f, 0.f, 0.f};
#pragma unroll
    for (int nt = 0; nt < 4; ++nt) {
      o[nt] = *(const f32x4*)(Ubuf + (size_t)chunk * 4096 + ((w * 4 + nt) * 64 + lane) * 4);
#pragma unroll
      for (int r = 0; r < 4; ++r) ss[r] += o[nt][r] * o[nt][r];
    }
#pragma unroll
    for (int r = 0; r < 4; ++r) {
      float s = ss[r];
      s += __shfl_xor(s, 1); s += __shfl_xor(s, 2); s += __shfl_xor(s, 4); s += __shfl_xor(s, 8);
      ss[r] = rsqrtf(s * (1.f / 64.f) + EPS);
    }
#pragma unroll
    for (int nt = 0; nt < 4; ++nt) {
      const float gn = p.dn_norm[nt * 16 + fr];
#pragma unroll
      for (int r = 0; r < 4; ++r) {
        size_t tok = (size_t)b * 8192 + n * 64 + w * 16 + fq * 4 + r;
        float z = bf2f(p_proj[tok * INW + 2304 + h * 64 + nt * 16 + fr]);
        p_mix[tok * DM + 512 + h * 64 + nt * 16 + fr] = f2bf(o[nt][r] * ss[r] * gn * silu(z));
      }
    }
  }
}

__device__ void ph_norm_ffn(const P& p) {
  const int lane = tid_() & 63, wid = tid_() >> 6;
  for (int it = blockIdx.x; it < TT / 16; it += gridDim.x) {
    int t0 = it * 16 + wid * 4;
    rms_rows<4>([&](int t) { return (const float*)(p.out + (size_t)t * DM); }, p.norm_ffn, p_Abf, t0, lane);
  }
}
__device__ void ph_final(const P& p) {
  const int lane = tid_() & 63, wid = tid_() >> 6;
  f32x4 g[4];
#pragma unroll
  for (int i = 0; i < 4; ++i) g[i] = *(const f32x4*)(p.norm_final + i * 256 + lane * 4);
  for (int it = blockIdx.x; it < TT / 16; it += gridDim.x) {
    const int t0 = it * 16 + wid * 4;
    uint2 hb[4][4];
#pragma unroll
    for (int r = 0; r < 4; ++r)
#pragma unroll
      for (int i = 0; i < 4; ++i) hb[r][i] = *(const uint2*)(p_h16 + (size_t)(t0 + r) * DM + i * 256 + lane * 4);
#pragma unroll
    for (int r = 0; r < 4; ++r) {
      f32x4 v[4];
      float ss = 0.f;
#pragma unroll
      for (int i = 0; i < 4; ++i) {
        v[i] = f32x4{bflo(hb[r][i].x), bfhi(hb[r][i].x), bflo(hb[r][i].y), bfhi(hb[r][i].y)};
        ss += v[i][0] * v[i][0] + v[i][1] * v[i][1] + v[i][2] * v[i][2] + v[i][3] * v[i][3];
      }
      ss = wave_sum(ss);
      const float rs = rsqrtf(ss * (1.f / 1024.f) + EPS);
#pragma unroll
      for (int i = 0; i < 4; ++i) *(f32x4*)(p.out + (size_t)(t0 + r) * DM + i * 256 + lane * 4) = v[i] * rs * g[i];
    }
  }
}

#define CE1(a, b) { int hi_ = max((a), (b)), lo_ = min((a), (b)); (a) = hi_; (b) = lo_; }
__device__ __forceinline__ int key_pack(float v, int payload, int mask) {
  int b = (__float_as_int(v) & ~mask) | payload;
  return b ^ ((b >> 31) & 0x7fffffff);
}
__device__ __forceinline__ int key_unmap(int k) { return k ^ ((k >> 31) & 0x7fffffff); }
__device__ __forceinline__ void sort16p(int (&v)[16]) {
#pragma unroll
  for (int k = 2; k <= 16; k <<= 1)
#pragma unroll
    for (int j = k >> 1; j > 0; j >>= 1)
#pragma unroll
      for (int i = 0; i < 16; ++i) {
        int l = i ^ j;
        if (l > i) {
          if ((i & k) == 0) { CE1(v[i], v[l]); }
          else { CE1(v[l], v[i]); }
        }
      }
}
__device__ __forceinline__ void merge16p(int (&a)[16], const int (&b)[16]) {
#pragma unroll
  for (int i = 0; i < 16; ++i) a[i] = max(a[i], b[15 - i]);
#pragma unroll
  for (int j = 8; j > 0; j >>= 1)
#pragma unroll
    for (int i = 0; i < 16; ++i) {
      int l = i ^ j;
      if (l > i) { CE1(a[i], a[l]); }
    }
}
__device__ __forceinline__ void xmerge16p(int (&a)[16], int mask) {
  int b[16];
#pragma unroll
  for (int i = 0; i < 16; ++i) b[i] = (mask == 16) ? __builtin_amdgcn_ds_swizzle(a[i], 0x401F) : __shfl_xor(a[i], 32);
  merge16p(a, b);
}

__device__ void ph_score(const P& p, int* lds) {
  const int lane = tid_() & 63, w = tid_() >> 6, fr = lane & 15, fq = lane >> 4;
  const u16* Qb = p_proj;
  int* experts = (int*)p_mix;
  float* gates = (float*)(p_mix) + (size_t)TT * 128;
  int* myl = lds + w * 512 + fr * 32;
  for (int it = blockIdx.x; it < 528 * 8; it += gridDim.x) {
    const int h = it & 7, tile = it >> 3;
    const size_t tok = (size_t)tile * 64 + w * 16 + fr;
    float tv[2][16];
#pragma unroll
    for (int half = 0; half < 2; ++half) {
      const u16* Kb = (half ? p_K2b : p_K1b) + h * 128 * 128;
      f32x4 sc[8];
#pragma unroll
      for (int mt = 0; mt < 8; ++mt) sc[mt] = f32x4{0.f, 0.f, 0.f, 0.f};
#pragma unroll
      for (int ks = 0; ks < 4; ++ks) {
        bf16x8 qf = *(const bf16x8*)(Qb + tok * 2048 + h * 256 + half * 128 + ks * 32 + fq * 8);
#pragma unroll
        for (int mt = 0; mt < 8; ++mt) {
          bf16x8 kf = *(const bf16x8*)(Kb + (mt * 16 + fr) * 128 + ks * 32 + fq * 8);
          sc[mt] = mfma16(kf, qf, sc[mt]);
        }
      }
      int a[16], b[16];
#pragma unroll
      for (int mt = 0; mt < 4; ++mt)
#pragma unroll
        for (int r = 0; r < 4; ++r) {
          a[mt * 4 + r] = key_pack(sc[mt][r], mt * 16 + fq * 4 + r, 0x7f);
          b[mt * 4 + r] = key_pack(sc[mt + 4][r], (mt + 4) * 16 + fq * 4 + r, 0x7f);
        }
      sort16p(a);
      __builtin_amdgcn_sched_barrier(0);
      sort16p(b);
      __builtin_amdgcn_sched_barrier(0);
      merge16p(a, b);
      xmerge16p(a, 16); xmerge16p(a, 32);
      __builtin_amdgcn_sched_barrier(0);
      int idx4[4];
#pragma unroll
      for (int i = 0; i < 16; ++i) {
        const int k = key_unmap(a[i]);
        tv[half][i] = __int_as_float(k & ~0x7f);
        if ((i >> 2) == 0) idx4[i & 3] = k & 0x7f;
      }
#pragma unroll
      for (int i = 4; i < 16; ++i) {
        const int k = key_unmap(a[i]) & 0x7f;
        if ((i >> 2) == 1) idx4[i & 3] = (fq == 1) ? k : idx4[i & 3];
        if ((i >> 2) == 2) idx4[i & 3] = (fq == 2) ? k : idx4[i & 3];
        if ((i >> 2) == 3) idx4[i & 3] = (fq == 3) ? k : idx4[i & 3];
      }
      *(int4*)(myl + half * 16 + fq * 4) = make_int4(idx4[0], idx4[1], idx4[2], idx4[3]);
    }
    int L0[16];
#pragma unroll
    for (int rr = 0; rr < 4; ++rr) {
      const float v1 = fq == 0 ? tv[0][rr] : (fq == 1 ? tv[0][4 + rr] : (fq == 2 ? tv[0][8 + rr] : tv[0][12 + rr]));
      int Lr[16];
#pragma unroll
      for (int j = 0; j < 16; ++j) Lr[j] = key_pack(v1 + tv[1][j], ((fq * 4 + rr) << 4) | j, 0xff);
      if (rr == 0) {
#pragma unroll
        for (int j = 0; j < 16; ++j) L0[j] = Lr[j];
      } else {
        merge16p(L0, Lr);
      }
      __builtin_amdgcn_sched_barrier(0);
    }
    xmerge16p(L0, 16); xmerge16p(L0, 32);
    float e[16], sum = 0.f; int ci[16];
    const float smax = __int_as_float(key_unmap(L0[0]) & ~0xff);
#pragma unroll
    for (int i = 0; i < 16; ++i) {
      const int k = key_unmap(L0[i]);
      ci[i] = k & 0xff;
      e[i] = __expf(__int_as_float(k & ~0xff) - smax);
      sum += e[i];
    }
    const float inv = 1.f / sum;
    int c4[4]; float g4[4];
#pragma unroll
    for (int rr = 0; rr < 4; ++rr) {
      c4[rr] = fq == 0 ? ci[rr] : (fq == 1 ? ci[4 + rr] : (fq == 2 ? ci[8 + rr] : ci[12 + rr]));
      g4[rr] = (fq == 0 ? e[rr] : (fq == 1 ? e[4 + rr] : (fq == 2 ? e[8 + rr] : e[12 + rr]))) * inv;
    }
    __builtin_amdgcn_s_waitcnt(0xc07f);
    __builtin_amdgcn_wave_barrier();
    int ex4[4];
#pragma unroll
    for (int rr = 0; rr < 4; ++rr) ex4[rr] = (myl[c4[rr] >> 4] << 7) | myl[16 + (c4[rr] & 15)];
    *(int4*)(experts + tok * 128 + h * 16 + fq * 4) = make_int4(ex4[0], ex4[1], ex4[2], ex4[3]);
    *(float4*)(gates + tok * 128 + h * 16 + fq * 4) = make_float4(g4[0], g4[1], g4[2], g4[3]);
    __builtin_amdgcn_wave_barrier();
  }
}

#define XB_TMO      128
#define XB_XCNT(j)  (256  + 64 * (j))
#define XB_XSUB(j)  (1280 + 64 * (j))
#define XB_XGEN(j)  (2304 + 64 * (j))
#define XB_TOP      3328
#define XB_TOPGEN   3392
#define XCD_BAR_WORDS 3456
#define XB_SPIN_CAP (1u << 18)
#define LAS __attribute__((address_space(3)))
__device__ __forceinline__ unsigned xb_ld(unsigned* p)              { return __hip_atomic_load(p, __ATOMIC_RELAXED, __HIP_MEMORY_SCOPE_AGENT); }
__device__ __forceinline__ unsigned xb_add(unsigned* p, unsigned v) { return __hip_atomic_fetch_add(p, v, __ATOMIC_RELAXED, __HIP_MEMORY_SCOPE_AGENT); }
__device__ __forceinline__ unsigned xb_xcc_id() { return (unsigned)__builtin_amdgcn_s_getreg((3 << 11) | 20) & 0xFu; }
#define XB_SPIN(cond, bar) do { unsigned _sp = 0; while (cond) { __builtin_amdgcn_s_sleep(1); \
    if ((++_sp & 255u) == 0u) { if (xb_ld(&(bar)[XB_TMO])) break; if (_sp > XB_SPIN_CAP) { atomicAdd(&(bar)[XB_TMO], 1u); break; } } } } while (0)
struct XcdBarrier { unsigned* bar; unsigned x; volatile LAS unsigned* st; };
__device__ __forceinline__ XcdBarrier xcd_barrier_post(unsigned* bar, volatile LAS unsigned* st) {
    XcdBarrier b; b.bar = bar; b.x = xb_xcc_id(); b.st = st;
    if (tid_() == 0) st[2] = xb_add(&bar[XB_XCNT(b.x)], 1u);
    return b;
}
__device__ __forceinline__ void xcd_barrier_complete(unsigned* bar, unsigned x, unsigned& nloc, unsigned& nx) {
    const unsigned G = gridDim.x * gridDim.y * gridDim.z;
    unsigned sum, cnt, mine, sp = 0u;
    for (;;) {
        sum = 0u; cnt = 0u; mine = 0u;
#pragma unroll
        for (unsigned j = 0; j < 16; ++j) { const unsigned c = xb_ld(&bar[XB_XCNT(j)]); sum += c; cnt += (c > 0u) ? 1u : 0u; mine = (j == x) ? c : mine; }
        if (sum == G) break;
        __builtin_amdgcn_s_sleep(1);
        if ((++sp & 255u) == 0u) { if (xb_ld(&bar[XB_TMO])) break; if (sp > XB_SPIN_CAP) { atomicAdd(&bar[XB_TMO], 1u); break; } }
    }
    nloc = mine > 0u ? mine : 1u; nx = cnt > 0u ? cnt : 1u;
}
__device__ __forceinline__ void xcd_barrier(const XcdBarrier& b) {
    asm volatile("s_waitcnt vmcnt(0)" ::: "memory");
    __syncthreads();
    if (tid_() == 0) {
        unsigned* bar = b.bar;
        __builtin_amdgcn_s_waitcnt(0);
        unsigned nloc = b.st[0], nx = b.st[1];
        if (nloc == 0u) { xcd_barrier_complete(bar, b.x, nloc, nx); b.st[0] = nloc; b.st[1] = nx; }
        const unsigned old = xb_add(&bar[XB_XSUB(b.x)], 1u);
        const unsigned gen = old / nloc;
        if (old + 1u == (gen + 1u) * nloc) {
            __builtin_amdgcn_fence(__ATOMIC_RELEASE, "agent");
            asm volatile("s_waitcnt vmcnt(0)" ::: "memory");
            const unsigned og = xb_add(&bar[XB_TOP], 1u);
            const unsigned tg = og / nx;
            if (og + 1u == (tg + 1u) * nx) xb_add(&bar[XB_TOPGEN], 1u);
            else XB_SPIN(xb_ld(&bar[XB_TOPGEN]) == tg, bar);
            __builtin_amdgcn_fence(__ATOMIC_ACQUIRE, "agent");
            xb_add(&bar[XB_XGEN(b.x)], 1u);
            asm volatile("s_waitcnt vmcnt(0)" ::: "memory");
        } else {
            XB_SPIN(xb_ld(&bar[XB_XGEN(b.x)]) == gen, bar);
            __builtin_amdgcn_fence(__ATOMIC_ACQUIRE, "agent");
            asm volatile("s_waitcnt vmcnt(0)" ::: "memory");
        }
    }
    __syncthreads();
}

__device__ __forceinline__ void dec16(u32x4 q, f32x2 (&v)[8]) {
#pragma unroll
  for (int k = 0; k < 4; ++k) {
    v[2 * k] = __builtin_amdgcn_cvt_pk_f32_fp8((int)q[k], false);
    v[2 * k + 1] = __builtin_amdgcn_cvt_pk_f32_fp8((int)q[k], true);
  }
}
__device__ __forceinline__ void xcd_slice(const P& p, int xcc, int xrank, int& x, int& rank, int& nblk) {
  unsigned c[8]; unsigned sum = 0; bool all = true;
#pragma unroll
  for (int j = 0; j < 8; ++j) { c[j] = xb_ld(&p_bar[XB_XCNT(j)]); sum += c[j]; all = all && (c[j] > 0u); }
  if (all && sum == gridDim.x) {
    x = xcc; rank = xrank;
    unsigned m = c[0];
#pragma unroll
    for (int j = 1; j < 8; ++j) m = (j == xcc) ? c[j] : m;
    nblk = (int)m;
  } else {
    x = blockIdx.x & 7; rank = blockIdx.x >> 3; nblk = (gridDim.x + 7 - x) >> 3;
  }
}

__device__ void ph_expert_u(const P& p, int xcc, int xrank) {
  const int lane = tid_() & 63, wid = tid_() >> 6, g = lane >> 3, cc = lane & 7;
  int x, rank, nblk;
  xcd_slice(p, xcc, xrank, x, rank, nblk);
  const int nw = nblk * 4, w0 = rank * 4 + wid;
  const int* experts = (const int*)p_mix + g;
  float* partial = (float*)p_proj + (size_t)x * TT * 128 + g;
  const unsigned char* tab = p_U8 + (size_t)x * 16384 * 128 + cc * 16;
  const u16* cbase = p_Abf + x * 128 + cc * 16;
  auto load_ex = [&](int t, int (&ex)[16]) {
    t = t < TT ? t : TT - 1;
#pragma unroll
    for (int i = 0; i < 16; ++i) ex[i] = experts[(size_t)t * 128 + i * 8];
  };
  auto load_c = [&](int t, u32x4& c0, u32x4& c1) {
    t = t < TT ? t : TT - 1;
    c0 = *(const u32x4*)(cbase + (size_t)t * DM); c1 = *(const u32x4*)(cbase + (size_t)t * DM + 8);
  };
  auto dot8 = [&](float (&sm)[16], int hf, const f32x2 (&cf)[8], const u32x4 (&rows)[8]) {
#pragma unroll
    for (int i = 0; i < 8; ++i) {
      f32x2 v[8];
      dec16(rows[i], v);
      f32x2 s2 = cf[0] * v[0];
#pragma unroll
      for (int k = 1; k < 8; ++k) s2 += cf[k] * v[k];
      sm[hf * 8 + i] = s2[0] + s2[1];
    }
  };
  const int slot0 = ((cc >> 2) & 1) * 8 + ((cc >> 1) & 1) * 4 + (cc & 1) * 2;
  auto reduce_store = [&](int t, float (&sm)[16]) {
    const bool h2 = (cc & 4) != 0, h1 = (cc & 2) != 0, h0 = (cc & 1) != 0;
#pragma unroll
    for (int k = 0; k < 8; ++k) {
      float send = h2 ? sm[k] : sm[k + 8]; float keep = h2 ? sm[k + 8] : sm[k];
      sm[k] = keep + __int_as_float(__builtin_amdgcn_ds_swizzle(__float_as_int(send), 0x101F));
    }
#pragma unroll
    for (int k = 0; k < 4; ++k) { float send = h1 ? sm[k] : sm[k + 4]; float keep = h1 ? sm[k + 4] : sm[k]; sm[k] = keep + dpp_f<DPP_XOR2>(send); }
#pragma unroll
    for (int k = 0; k < 2; ++k) { float send = h0 ? sm[k] : sm[k + 2]; float keep = h0 ? sm[k + 2] : sm[k]; sm[k] = keep + dpp_f<DPP_XOR1>(send); }
    partial[(size_t)t * 128 + slot0 * 8] = sm[0];
    partial[(size_t)t * 128 + slot0 * 8 + 8] = sm[1];
  };
  int t = w0;
  if (t >= TT) return;
  int exU[16], exN[16]; u32x4 rP[8], rQ[8]; u32x4 c0, c1, n0, n1;
  load_ex(t, exU); load_c(t, c0, c1);
#pragma unroll
  for (int i = 0; i < 8; ++i) rP[i] = *(const u32x4*)(tab + (size_t)exU[i] * 128);
  load_ex(t + nw, exN); load_c(t + nw, n0, n1);
  for (; t < TT; t += nw) {
#pragma unroll
    for (int i = 0; i < 8; ++i) rQ[i] = *(const u32x4*)(tab + (size_t)exU[8 + i] * 128);
    f32x2 cf[8];
#pragma unroll
    for (int k = 0; k < 4; ++k) { cf[k] = f32x2{bflo(c0[k]), bfhi(c0[k])}; cf[4 + k] = f32x2{bflo(c1[k]), bfhi(c1[k])}; }
    float sm[16];
    __builtin_amdgcn_sched_barrier(0);
    dot8(sm, 0, cf, rP);
    __builtin_amdgcn_sched_barrier(0);
#pragma unroll
    for (int i = 0; i < 8; ++i) rP[i] = *(const u32x4*)(tab + (size_t)exN[i] * 128);
    __builtin_amdgcn_sched_barrier(0);
    dot8(sm, 1, cf, rQ);
    __builtin_amdgcn_sched_barrier(0);
    reduce_store(t, sm);
    __builtin_amdgcn_sched_barrier(0);
#pragma unroll
    for (int i = 0; i < 16; ++i) exU[i] = exN[i];
    c0 = n0; c1 = n1;
    load_ex(t + 2 * nw, exN); load_c(t + 2 * nw, n0, n1);
  }
}

__device__ void ph_expert_red(const P& p) {
  const int lane = tid_() & 63, wid = tid_() >> 6;
  float* gates = (float*)(p_mix) + (size_t)TT * 128;
  const float* partial = (const float*)p_proj;
  for (int it = blockIdx.x; it < TT / 8; it += gridDim.x) {
    const size_t t0 = (size_t)it * 8 + wid * 2;
    float pv[2][2][8], gv[2][2], rs[2];
#pragma unroll
    for (int k = 0; k < 2; ++k) {
#pragma unroll
      for (int hf = 0; hf < 2; ++hf) {
#pragma unroll
        for (int x = 0; x < 8; ++x) pv[k][hf][x] = partial[((size_t)x * TT + t0 + k) * 128 + hf * 64 + lane];
        gv[k][hf] = gates[(t0 + k) * 128 + hf * 64 + lane];
      }
      rs[k] = p_ssq2[t0 + k];
    }
#pragma unroll
    for (int k = 0; k < 2; ++k) {
      const float sc = (1.f / SU) * rsqrtf(rs[k] * (1.f / 1024.f) + EPS);
#pragma unroll
      for (int hf = 0; hf < 2; ++hf) {
        float a = 0.f;
#pragma unroll
        for (int x = 0; x < 8; ++x) a += pv[k][hf][x];
        a *= sc;
        const float act = 0.5f * a * (1.f + erff(a * 0.70710678118654752f));
        gates[(t0 + k) * 128 + hf * 64 + lane] = gv[k][hf] * act;
      }
    }
  }
}

__device__ void ph_expert_v(const P& p, int xcc, int xrank) {
  const int lane = tid_() & 63, wid = tid_() >> 6, g = lane >> 3, cc = lane & 7;
  int x, rank, nblk;
  xcd_slice(p, xcc, xrank, x, rank, nblk);
  const int nw = nblk * 4, w0 = rank * 4 + wid;
  const int* experts = (const int*)p_mix + g;
  const float* gates = (const float*)(p_mix) + (size_t)TT * 128 + g;
  const unsigned char* tab = p_V8 + (size_t)x * 16384 * 128 + cc * 16;
  const int col = x * 128 + cc * 16 + ((g >> 2) & 1) * 8 + ((g >> 1) & 1) * 4 + (g & 1) * 2;
  const float gn0 = p.norm_ple[col], gn1 = p.norm_ple[col + 1];
  auto load_ex = [&](int t, int (&ex)[16]) {
    t = t < TT ? t : TT - 1;
#pragma unroll
    for (int i = 0; i < 16; ++i) ex[i] = experts[(size_t)t * 128 + i * 8];
  };
  auto load8 = [&](int t, int hf, const int (&ex)[16], u32x4 (&rows)[8], float (&wv)[8]) {
    t = t < TT ? t : TT - 1;
#pragma unroll
    for (int i = 0; i < 8; ++i) { rows[i] = *(const u32x4*)(tab + (size_t)ex[hf * 8 + i] * 128); wv[i] = gates[(size_t)t * 128 + (hf * 8 + i) * 8]; }
  };
  auto acc8 = [&](f32x2 (&y2)[8], const float (&wv)[8], const u32x4 (&rows)[8]) {
#pragma unroll
    for (int i = 0; i < 8; ++i) {
      f32x2 v[8];
      dec16(rows[i], v);
      const f32x2 w2 = f32x2{wv[i], wv[i]};
#pragma unroll
      for (int k = 0; k < 8; ++k) y2[k] += w2 * v[k];
    }
  };
  auto finish = [&](int t, float2 hv, const f32x2 (&y2)[8]) {
    float y[16];
#pragma unroll
    for (int k = 0; k < 8; ++k) { y[2 * k] = y2[k][0]; y[2 * k + 1] = y2[k][1]; }
    {
      const bool h5 = (lane & 32) != 0;
#pragma unroll
      for (int k = 0; k < 8; ++k) { float send = h5 ? y[k] : y[k + 8]; float keep = h5 ? y[k + 8] : y[k]; y[k] = keep + __shfl_xor(send, 32); }
      const bool h4 = (lane & 16) != 0;
#pragma unroll
      for (int k = 0; k < 4; ++k) { float send = h4 ? y[k] : y[k + 4]; float keep = h4 ? y[k + 4] : y[k]; y[k] = keep + __shfl_xor(send, 16); }
      const bool h3 = (lane & 8) != 0;
#pragma unroll
      for (int k = 0; k < 2; ++k) { float send = h3 ? y[k] : y[k + 2]; float keep = h3 ? y[k + 2] : y[k]; y[k] = keep + __shfl_xor(send, 8); }
    }
    hv.x += y[0] * (1.f / SV); hv.y += y[1] * (1.f / SV);
    *(unsigned*)(p_h16 + (size_t)t * DM + col) = pack2(hv.x, hv.y);
    float ss = wave_sum(hv.x * hv.x + hv.y * hv.y);
    if (lane == 0) atomicAdd(p_ssq + t, ss);
    *(unsigned*)(p_Abf + (size_t)t * DM + col) = pack2(hv.x * gn0, hv.y * gn1);
  };
  int t = w0;
  if (t >= TT) return;
  int exU[16], exN[16]; u32x4 rP[8], rQ[8]; float wP[8], wQ[8];
  load_ex(t, exU);
  load8(t, 0, exU, rP, wP);
  load_ex(t + nw, exN);
  for (; t < TT; t += nw) {
    load8(t, 1, exU, rQ, wQ);
    const unsigned hvb = *(const unsigned*)(p_h16 + (size_t)t * DM + col);
    const float2 hv0 = make_float2(bflo(hvb), bfhi(hvb));
    f32x2 y2[8];
#pragma unroll
    for (int k = 0; k < 8; ++k) y2[k] = f32x2{0.f, 0.f};
    acc8(y2, wP, rP);
    load8(t + nw, 0, exN, rP, wP);
    acc8(y2, wQ, rQ);
    finish(t, hv0, y2);
#pragma unroll
    for (int i = 0; i < 16; ++i) exU[i] = exN[i];
    load_ex(t + 2 * nw, exN);
  }
}

__global__ void __launch_bounds__(256, 2) mega(P p) {
  __shared__ __attribute__((aligned(16))) float lds_f[14340];
  cg::grid_group grid = cg::this_grid();
  uint4& xb_words = *(uint4*)&lds_f[14336];
  if (tid_() == 0) xb_words = make_uint4(0u, 0u, 0u, 0u);
  __syncthreads();
  (void)xcd_barrier_post(p_bar, (volatile LAS unsigned*)&xb_words);
#ifndef PHMASK
#define PHMASK 0x3fff
#endif
#define PHON(i) ((PHMASK >> (i)) & 1)
#define PHASE(i, call) if (p.ph_lo <= (i) && (i) < p.ph_hi) { if (PHON(i)) { call; } if ((i) + 1 < p.ph_hi) { XcdBarrier xb_; xb_.bar = p_bar; xb_.x = xb_xcc_id(); xb_.st = (volatile LAS unsigned*)&xb_words; xcd_barrier(xb_); } }
  if (p.ph_lo <= 0 && 0 < p.ph_hi) { if (PHON(0)) { ph_prep(p, lds_f); } if (1 < p.ph_hi) grid.sync(); }
  PHASE(1, ph_gemm1(p, (u16*)lds_f))
  PHASE(2, ph_dnpre(p, lds_f))
  PHASE(3, ph_mixer(p, (u16*)lds_f))
  PHASE(4, ph_gatenorm(p))
  PHASE(5, ph_gemm2(p, (u16*)lds_f))
  PHASE(7, ph_gemm3(p, (u16*)lds_f))
  PHASE(8, ph_score(p, (int*)lds_f))
  PHASE(9, ph_expert_u(p, (int)xb_xcc_id(), (int)xb_words.z))
  PHASE(10, ph_expert_red(p))
  PHASE(11, ph_expert_v(p, (int)xb_xcc_id(), (int)xb_words.z))
  PHASE(12, ph_gemm4(p, (u16*)lds_f))
  PHASE(13, ph_final(p))
}

extern "C" void kernel_launch(void* const* d_in, const int* in_sizes, int n_in, void* d_out, int out_size, void* d_ws,
                              size_t ws_size, hipStream_t stream) {
  static int grid_blocks = 0;
  if (!grid_blocks) {
    int dev = 0, cus = 0, per_cu = 0;
    hipGetDevice(&dev);
    hipDeviceGetAttribute(&cus, hipDeviceAttributeMultiprocessorCount, dev);
    hipOccupancyMaxActiveBlocksPerMultiprocessor(&per_cu, mega, 256, 0);
    if (per_cu > 2) per_cu = 2;
    grid_blocks = cus * per_cu;
  }
  P p;
  memset(&p, 0, sizeof(p));
  const float** f = (const float**)&p;
  for (int i = 0; i < 26; ++i) f[i] = (const float*)d_in[i];
  p.out = (float*)d_out;
  p.ws = (char*)d_ws;
  p.ph_lo = 0; p.ph_hi = 14;
  hipMemsetAsync((char*)d_ws + 396283904ull, 0, (size_t)XCD_BAR_WORDS * 4, stream);
  void* args[] = {&p};
  hipError_t e = hipLaunchCooperativeKernel((void*)mega, dim3(grid_blocks), dim3(256), args, 0, stream);
  if (e != hipSuccess) fprintf(stderr, "cooperative launch failed: %s (grid %d)\n", hipGetErrorString(e), grid_blocks);
}
```

```cpp
#include <hip/hip_runtime.h>
#include <hip/hip_cooperative_groups.h>
#include <cstdio>
#include <cstring>
namespace cg = cooperative_groups;

typedef unsigned short u16;
using bf16x8 = __attribute__((ext_vector_type(8))) short;
using f32x4 = __attribute__((ext_vector_type(4))) float;
using u32x4 = __attribute__((ext_vector_type(4))) unsigned int;
using f32x2 = __attribute__((ext_vector_type(2))) float;
#define SU 64.f
#define SV 16.f
typedef __bf16 bf16x2_hw __attribute__((ext_vector_type(2)));
__device__ __forceinline__ unsigned pack2(float a, float b) {
  f32x2 v = {a, b};
  return __builtin_bit_cast(unsigned, __builtin_convertvector(v, bf16x2_hw));
}
__device__ __forceinline__ u16 f2bf(float f) { return (u16)(pack2(f, 0.f) & 0xffffu); }

#define TP 32768
#define TS 1024
#define TT 33792
#define DM 1024
#define INW 2832
#define EPS 1e-6f

#define O_Y 0
#define O_KP 34603008
#define O_VP 34668544
#define O_CP 34734080
#define O_DP 34752512
#define O_KS 34883584
#define O_VS 36980736
#define O_CS 39077888
#define O_DS 39667712

struct P {
  const float *x_p, *x_s, *p_p, *p_s, *ck, *cv, *sconv, *sdelta, *norm_mix, *w_in, *conv_w, *sinks, *a_log,
      *dt_bias, *dn_norm, *w_out, *norm_ffn, *wq, *keys1, *keys2, *pu, *pv, *norm_ple, *ple_in, *ple_gate, *norm_final;
  float* out;
  char* ws;
  int ph_lo, ph_hi;
};
#define p_WinT ((u16*)(p.ws + 0ull))
#define p_WoutT ((u16*)(p.ws + 6029312ull))
#define p_WqT ((u16*)(p.ws + 8126464ull))
#define p_WgT ((u16*)(p.ws + 12320768ull))
#define p_WpT ((u16*)(p.ws + 14417920ull))
#define p_K1b ((u16*)(p.ws + 14942208ull))
#define p_K2b ((u16*)(p.ws + 15204352ull))
#define p_U8 ((unsigned char*)(p.ws + 15466496ull))
#define p_V8 ((unsigned char*)(p.ws + 32243712ull))
#define p_Pb ((u16*)(p.ws + 49020928ull))
#define p_Abf ((u16*)(p.ws + 66322432ull))
#define p_proj ((u16*)(p.ws + 135528448ull))
#define p_mix ((u16*)(p.ws + 326926336ull))
#define p_gl ((float*)(p.ws + 396132352ull))
#define p_ssq ((float*)(p.ws + 396148736ull))
#define p_bar ((unsigned*)(p.ws + 396283904ull))
#define p_Obuf ((float*)(p.ws + 396297728ull))
#define p_ssq2 ((float*)(p.ws + 463406592ull))
#define p_h16 ((u16*)(p.ws + 463541760ull))


__device__ __forceinline__ int tid_() { int t = threadIdx.x; asm volatile("" : "+v"(t)); return t; }
__device__ __forceinline__ float bf2f(u16 h) { return __uint_as_float(((unsigned)h) << 16); }

__device__ __forceinline__ float bflo(unsigned u) { return __uint_as_float(u << 16); }
__device__ __forceinline__ float bfhi(unsigned u) { return __uint_as_float(u & 0xffff0000u); }
union BF8 { bf16x8 v; uint4 q; unsigned u[4]; };
__device__ __forceinline__ bf16x8 pack8(float a0, float a1, float a2, float a3, float a4, float a5, float a6, float a7) {
  BF8 t; t.u[0] = pack2(a0, a1); t.u[1] = pack2(a2, a3); t.u[2] = pack2(a4, a5); t.u[3] = pack2(a6, a7); return t.v;
}
__device__ __forceinline__ bf16x8 pack8v(f32x4 a, f32x4 b) { return pack8(a[0], a[1], a[2], a[3], b[0], b[1], b[2], b[3]); }
__device__ __forceinline__ uint2 pack4v(f32x4 a) { uint2 r; r.x = pack2(a[0], a[1]); r.y = pack2(a[2], a[3]); return r; }
template <int CTRL>
__device__ __forceinline__ float dpp_f(float v) {
  return __int_as_float(__builtin_amdgcn_update_dpp(0, __float_as_int(v), CTRL, 0xf, 0xf, true));
}
#define DPP_XOR1 0xB1
#define DPP_XOR2 0x4E
#define DPP_HMIRROR 0x141
#define DPP_MIRROR 0x140
__device__ __forceinline__ float wave_sum(float v) {
  v += dpp_f<DPP_XOR1>(v);
  v += dpp_f<DPP_XOR2>(v);
  v += dpp_f<DPP_HMIRROR>(v);
  v += dpp_f<DPP_MIRROR>(v);
  float a = __int_as_float(__builtin_amdgcn_readlane(__float_as_int(v), 0));
  float b = __int_as_float(__builtin_amdgcn_readlane(__float_as_int(v), 16));
  float c = __int_as_float(__builtin_amdgcn_readlane(__float_as_int(v), 32));
  float d = __int_as_float(__builtin_amdgcn_readlane(__float_as_int(v), 48));
  return (a + b) + (c + d);
}
__device__ __forceinline__ float silu(float y) { return y / (1.f + __expf(-y)); }
__device__ __forceinline__ float sigmoidf(float y) { return 1.f / (1.f + __expf(-y)); }
__device__ __forceinline__ float softplusf(float x) { return x > 20.f ? x : log1pf(__expf(x)); }
__device__ __forceinline__ const float* xrow(const P& p, int t) {
  return t < TP ? p.x_p + (size_t)t * DM : p.x_s + (size_t)(t - TP) * DM;
}
__device__ __forceinline__ f32x4 mfma16(bf16x8 a, bf16x8 b, f32x4 c) { return __builtin_amdgcn_mfma_f32_16x16x32_bf16(a, b, c, 0, 0, 0); }

template <int NR, typename SRC>
__device__ __forceinline__ void rms_rows(SRC src, const float* __restrict__ g, u16* __restrict__ dst, int t0, int lane) {
  f32x4 v[NR][4];
#pragma unroll
  for (int r = 0; r < NR; ++r) {
    const float* sp = src(t0 + r);
#pragma unroll
    for (int i = 0; i < 4; ++i) v[r][i] = *(const f32x4*)(sp + i * 256 + lane * 4);
  }
  f32x4 gg[4];
#pragma unroll
  for (int i = 0; i < 4; ++i) gg[i] = *(const f32x4*)(g + i * 256 + lane * 4);
#pragma unroll
  for (int r = 0; r < NR; ++r) {
    float ss = 0.f;
#pragma unroll
    for (int i = 0; i < 4; ++i) ss += v[r][i][0] * v[r][i][0] + v[r][i][1] * v[r][i][1] + v[r][i][2] * v[r][i][2] + v[r][i][3] * v[r][i][3];
    ss = wave_sum(ss);
    const float rs = rsqrtf(ss * (1.f / 1024.f) + EPS);
#pragma unroll
    for (int i = 0; i < 4; ++i) {
      uint2 o; o.x = pack2(v[r][i][0] * rs * gg[i][0], v[r][i][1] * rs * gg[i][1]); o.y = pack2(v[r][i][2] * rs * gg[i][2], v[r][i][3] * rs * gg[i][3]);
      *(uint2*)(dst + (size_t)(t0 + r) * DM + i * 256 + lane * 4) = o;
    }
  }
}

__device__ __forceinline__ void conv_chunk4(const float* __restrict__ src, u16* __restrict__ dst, size_t base) {
  f32x4 a[4], b[4];
#pragma unroll
  for (int q = 0; q < 4; ++q) {
    size_t i = base + (size_t)q * 2048 + (size_t)tid_() * 8;
    a[q] = *(const f32x4*)(src + i); b[q] = *(const f32x4*)(src + i + 4);
  }
#pragma unroll
  for (int q = 0; q < 4; ++q) {
    size_t i = base + (size_t)q * 2048 + (size_t)tid_() * 8;
    BF8 t; t.u[0] = pack2(a[q][0], a[q][1]); t.u[1] = pack2(a[q][2], a[q][3]); t.u[2] = pack2(b[q][0], b[q][1]); t.u[3] = pack2(b[q][2], b[q][3]);
    *(uint4*)(dst + i) = t.q;
  }
}

__device__ __forceinline__ void conv_table_chunk4(const float* __restrict__ src, unsigned char* __restrict__ dst, size_t base, float scale) {
  f32x4 a[4], b[4];
#pragma unroll
  for (int q = 0; q < 4; ++q) {
    size_t i = base + (size_t)q * 2048 + (size_t)tid_() * 8;
    a[q] = *(const f32x4*)(src + i); b[q] = *(const f32x4*)(src + i + 4);
  }
#pragma unroll
  for (int q = 0; q < 4; ++q) {
    size_t i = base + (size_t)q * 2048 + (size_t)tid_() * 8;
    int w0 = 0, w1 = 0;
    w0 = __builtin_amdgcn_cvt_pk_fp8_f32(a[q][0] * scale, a[q][1] * scale, w0, false);
    w0 = __builtin_amdgcn_cvt_pk_fp8_f32(a[q][2] * scale, a[q][3] * scale, w0, true);
    w1 = __builtin_amdgcn_cvt_pk_fp8_f32(b[q][0] * scale, b[q][1] * scale, w1, false);
    w1 = __builtin_amdgcn_cvt_pk_fp8_f32(b[q][2] * scale, b[q][3] * scale, w1, true);
    size_t e = i >> 10; int col = (int)(i & 1023); int x = col >> 7;
    *(uint2*)(dst + ((size_t)x * 16384 + e) * 128 + (col & 127)) = make_uint2((unsigned)w0, (unsigned)w1);
  }
}

__device__ void ph_prep(const P& p, float* lds) {
  for (int i = blockIdx.x * 256 + tid_(); i < TT; i += gridDim.x * 256) { p_ssq[i] = 0.f; p_ssq2[i] = 0.f; }
  const int tid = tid_(), lane = tid & 63, wid = tid >> 6;
  const int NTR = 1824, NCV = 16 + 16 + 2048 + 2048 + 1024 + 32, NRM = TT / 16;
  for (int it = blockIdx.x; it < NTR + NCV + NRM; it += gridDim.x) {
    if (it < NTR) {
      const float* src; u16* dst; int K, N, ntn; int j = it;
      if (j < 736) { src = p.w_in; dst = p_WinT; K = 1024; N = INW; ntn = 46; }
      else if ((j -= 736) < 256) { src = p.w_out; dst = p_WoutT; K = 1024; N = 1024; ntn = 16; }
      else if ((j -= 256) < 512) { src = p.wq; dst = p_WqT; K = 1024; N = 2048; ntn = 32; }
      else if ((j -= 512) < 256) { src = p.ple_gate; dst = p_WgT; K = 1024; N = 1024; ntn = 16; }
      else { j -= 256; src = p.ple_in; dst = p_WpT; K = 256; N = 1024; ntn = 16; }
      int k0 = (j / ntn) * 64, n0 = (j % ntn) * 64;
      __syncthreads();
#pragma unroll
      for (int i = 0; i < 4; ++i) {
        int id = tid + i * 256, row = id >> 4, c4 = id & 15;
        int n = n0 + c4 * 4;
        float4 v = make_float4(0.f, 0.f, 0.f, 0.f);
        if (n < N) v = *(const float4*)(src + (size_t)(k0 + row) * N + n);
        float* d = lds + row * 65 + c4 * 4;
        d[0] = v.x; d[1] = v.y; d[2] = v.z; d[3] = v.w;
      }
      __syncthreads();
#pragma unroll
      for (int i = 0; i < 2; ++i) {
        int id = tid + i * 256, n = id >> 3, kc = id & 7;
        const float* s = lds + (kc * 8) * 65 + n;
        bf16x8 o = pack8(s[0], s[65], s[130], s[195], s[260], s[325], s[390], s[455]);
        *(bf16x8*)(dst + (size_t)(n0 + n) * K + k0 + kc * 8) = o;
      }
    } else if (it < NTR + NCV) {
      int j = it - NTR;
      if (j < 16) conv_chunk4(p.keys1, p_K1b, (size_t)j * 8192);
      else if ((j -= 16) < 16) conv_chunk4(p.keys2, p_K2b, (size_t)j * 8192);
      else if ((j -= 16) < 2048) conv_table_chunk4(p.pu, p_U8, (size_t)j * 8192, SU);
      else if ((j -= 2048) < 2048) conv_table_chunk4(p.pv, p_V8, (size_t)j * 8192, SV);
      else if ((j -= 2048) < 1024) conv_chunk4(p.p_p, p_Pb, (size_t)j * 8192);
      else { j -= 1024; conv_chunk4(p.p_s, p_Pb + (size_t)TP * 256, (size_t)j * 8192); }
    } else {
      int t0 = (it - NTR - NCV) * 16 + wid * 4;
      rms_rows<4>([&](int t) { return xrow(p, t); }, p.norm_mix, p_Abf, t0, lane);
    }
  }
}

#define GEMM_STAGE_B 16384
#define RAW_BARRIER() do { asm volatile("s_waitcnt lgkmcnt(0)" ::: "memory"); __builtin_amdgcn_s_barrier(); } while (0)
struct GemmOps { const u16 *a0, *a1, *b0, *b1; };
__device__ __forceinline__ GemmOps gemm_ops(const u16* A, int lda, const u16* B, int ldb) {
  const int lane = tid_() & 63, wid = tid_() >> 6, rr = lane >> 2, c = lane & 3;
  const int R0 = wid * 16 + rr, R1 = (wid + 4) * 16 + rr;
  GemmOps g;
  g.a0 = A + (size_t)R0 * lda + ((c ^ ((R0 >> 2) & 3)) << 3);
  g.a1 = A + (size_t)R1 * lda + ((c ^ ((R1 >> 2) & 3)) << 3);
  g.b0 = B + (size_t)R0 * ldb + ((c ^ ((R0 >> 2) & 3)) << 3);
  g.b1 = B + (size_t)R1 * ldb + ((c ^ ((R1 >> 2) & 3)) << 3);
  return g;
}
__device__ __forceinline__ void gemm_issue(const GemmOps& g, int kt, int buf, char* L) {
  const int wid = tid_() >> 6;
  char* sb = L + buf * GEMM_STAGE_B;
  __builtin_amdgcn_global_load_lds((const unsigned*)(g.a0 + kt * 32), (unsigned*)(sb + wid * 1024), 16, 0, 0);
  __builtin_amdgcn_global_load_lds((const unsigned*)(g.a1 + kt * 32), (unsigned*)(sb + (wid + 4) * 1024), 16, 0, 0);
  __builtin_amdgcn_global_load_lds((const unsigned*)(g.b0 + kt * 32), (unsigned*)(sb + 8192 + wid * 1024), 16, 0, 0);
  __builtin_amdgcn_global_load_lds((const unsigned*)(g.b1 + kt * 32), (unsigned*)(sb + 8192 + (wid + 4) * 1024), 16, 0, 0);
}
__device__ __forceinline__ void gemm_prologue(const GemmOps& g, u16* lds) {
  gemm_issue(g, 0, 0, (char*)lds); gemm_issue(g, 1, 1, (char*)lds);
}
template <bool PAD>
__device__ __forceinline__ void gemm_main(f32x4 (&acc)[4][4], const GemmOps& g, int K, u16* lds) {
  const int tid = tid_(), lane = tid & 63, wid = tid >> 6;
  const int wm = wid >> 1, wn = wid & 1, fr = lane & 15, fq = lane >> 4;
  char* L = (char*)lds;
  int offA[4], offB[4];
#pragma unroll
  for (int i = 0; i < 4; ++i) {
    const int Ra = wm * 64 + i * 16 + fr, Rb = wn * 64 + i * 16 + fr;
    offA[i] = Ra * 64 + ((fq ^ ((Ra >> 2) & 3)) << 4);
    offB[i] = 8192 + Rb * 64 + ((fq ^ ((Rb >> 2) & 3)) << 4);
  }
  auto comp = [&](int buf) __attribute__((always_inline)) {
    const char* sb = L + buf * GEMM_STAGE_B;
    bf16x8 a[4], b[4];
#pragma unroll
    for (int i = 0; i < 4; ++i) a[i] = *(const bf16x8*)(sb + offA[i]);
    const int jn = PAD ? (wn == 0 ? 1 : 0) : 4;
#pragma unroll
    for (int j = 0; j < 4; ++j) if (!PAD || j < jn) b[j] = *(const bf16x8*)(sb + offB[j]);
#pragma unroll
    for (int i = 0; i < 4; ++i)
#pragma unroll
      for (int j = 0; j < 4; ++j) if (!PAD || j < jn) acc[i][j] = mfma16(a[i], b[j], acc[i][j]);
  };
  const int nk = K >> 5;
#define GEMM_STEP(J, BUF, NBUF) do { asm volatile("s_waitcnt vmcnt(4)" ::: "memory"); RAW_BARRIER(); \
    if ((J) + 2 < nk) gemm_issue(g, (J) + 2, NBUF, L); comp(BUF); } while (0)
  int j = 0;
  for (; j + 3 <= nk - 1; j += 3) {
    GEMM_STEP(j, 0, 2);
    GEMM_STEP(j + 1, 1, 0);
    GEMM_STEP(j + 2, 2, 1);
  }
  GEMM_STEP(j, 0, 2);
  asm volatile("s_waitcnt vmcnt(0)" ::: "memory");
  RAW_BARRIER();
  comp(1);
#undef GEMM_STEP
}

__device__ __forceinline__ void zero_acc(f32x4 (&acc)[4][4]) {
#pragma unroll
  for (int i = 0; i < 4; ++i)
#pragma unroll
    for (int j = 0; j < 4; ++j) acc[i][j] = f32x4{0.f, 0.f, 0.f, 0.f};
}
#define ZERO_ACC(acc) zero_acc(acc)

#define EPS_STRIDE 68
template <typename PRE, typename OUT>
__device__ __forceinline__ void gemm_epilogue(f32x4 (&acc)[4][4], u16* lds, PRE pre, OUT out) {
  const int lane = tid_() & 63, wid = tid_() >> 6, fr = lane & 15, fq = lane >> 4;
  float* W = (float*)lds + 8192 + wid * (16 * EPS_STRIDE);
#pragma unroll
  for (int i = 0; i < 4; ++i) {
#pragma unroll
    for (int j = 0; j < 4; ++j)
#pragma unroll
      for (int r = 0; r < 4; ++r) W[(fq * 4 + r) * EPS_STRIDE + j * 16 + fr] = pre(i, j, r, acc[i][j][r]);
#pragma unroll
    for (int q = 0; q < 4; ++q) {
      const int row = q * 4 + (lane >> 4), c4 = lane & 15;
      const f32x4 v = *(const f32x4*)(W + row * EPS_STRIDE + c4 * 4);
      out(i * 16 + row, c4, v);
    }
  }
}

__device__ __forceinline__ float row16_sum(float v) {
  v += dpp_f<DPP_XOR1>(v); v += dpp_f<DPP_XOR2>(v); v += dpp_f<DPP_HMIRROR>(v); v += dpp_f<DPP_MIRROR>(v);
  return v;
}

__device__ void ph_gemm1(const P& p, u16* lds) {
  const int wid = tid_() >> 6, wm = wid >> 1, wn = wid & 1;
  const int NT = 23, NTILES = 264 * NT;
  int it = blockIdx.x;
  if (it >= NTILES) return;
  auto ops = [&](int t) __attribute__((always_inline)) { return gemm_ops(p_Abf + (size_t)(t / NT) * 128 * DM, DM, p_WinT + (size_t)(t % NT) * 128 * DM, DM); };
  GemmOps g = ops(it);
  __syncthreads();
  gemm_prologue(g, lds);
  while (true) {
    const int mt = it / NT, nt = it % NT;
    f32x4 acc[4][4]; ZERO_ACC(acc);
    if (nt == NT - 1) gemm_main<true>(acc, g, DM, lds); else gemm_main<false>(acc, g, DM, lds);
    const int itn = it + gridDim.x; const bool more = itn < NTILES;
    __syncthreads();
    if (more) { g = ops(itn); gemm_prologue(g, lds); }
    gemm_epilogue(acc, lds, [](int, int, int, float v) { return v; },
      [&](int rowl, int c4, f32x4 v) {
        const int m = mt * 128 + wm * 64 + rowl, n = nt * 128 + wn * 64 + c4 * 4;
        if (n < INW) *(uint2*)(p_proj + (size_t)m * INW + n) = pack4v(v);
      });
    if (!more) break;
    it = itn;
  }
}

__device__ void ph_gemm2(const P& p, u16* lds) {
  const int lane = tid_() & 63, wid = tid_() >> 6, wm = wid >> 1, wn = wid & 1;
  const int NT = 8, NTILES = 264 * NT;
  int it = blockIdx.x;
  if (it >= NTILES) return;
  auto ops = [&](int t) __attribute__((always_inline)) { return gemm_ops(p_mix + (size_t)(t / NT) * 128 * DM, DM, p_WoutT + (size_t)(t % NT) * 128 * DM, DM); };
  GemmOps g = ops(it);
  __syncthreads();
  gemm_prologue(g, lds);
  while (true) {
    const int mt = it / NT, nt = it % NT;
    f32x4 acc[4][4]; ZERO_ACC(acc);
    gemm_main<false>(acc, g, DM, lds);
    const int itn = it + gridDim.x; const bool more = itn < NTILES;
    __syncthreads();
    if (more) { g = ops(itn); gemm_prologue(g, lds); }
    const f32x4 g4 = *(const f32x4*)(p.norm_ffn + nt * 128 + wn * 64 + (lane & 15) * 4);
    gemm_epilogue(acc, lds, [](int, int, int, float v) { return v; },
      [&](int rowl, int c4, f32x4 v) {
        const int m = mt * 128 + wm * 64 + rowl, n = nt * 128 + wn * 64 + c4 * 4;
        const f32x4 hv = *(const f32x4*)(xrow(p, m) + n) + v;
        *(uint2*)(p_h16 + (size_t)m * DM + n) = pack4v(hv);
        *(uint2*)(p_Abf + (size_t)m * DM + n) = pack4v(hv * g4);
        const float part = row16_sum(hv[0] * hv[0] + hv[1] * hv[1] + hv[2] * hv[2] + hv[3] * hv[3]);
        if (c4 == 0) atomicAdd(p_ssq2 + m, part);
      });
    if (!more) break;
    it = itn;
  }
}

__device__ void ph_gemm3(const P& p, u16* lds) {
  const int wid = tid_() >> 6, wm = wid >> 1, wn = wid & 1;
  const int NT = 16, NTILES = 264 * NT;
  u16* Qb = p_proj;
  int it = blockIdx.x;
  if (it >= NTILES) return;
  auto ops = [&](int t) __attribute__((always_inline)) { return gemm_ops(p_Abf + (size_t)(t / NT) * 128 * DM, DM, p_WqT + (size_t)(t % NT) * 128 * DM, DM); };
  GemmOps g = ops(it);
  __syncthreads();
  gemm_prologue(g, lds);
  while (true) {
    const int mt = it / NT, nt = it % NT;
    f32x4 acc[4][4]; ZERO_ACC(acc);
    gemm_main<false>(acc, g, DM, lds);
    const int itn = it + gridDim.x; const bool more = itn < NTILES;
    __syncthreads();
    if (more) { g = ops(itn); gemm_prologue(g, lds); }
    gemm_epilogue(acc, lds, [](int, int, int, float v) { return v; },
      [&](int rowl, int c4, f32x4 v) {
        const int m = mt * 128 + wm * 64 + rowl, n = nt * 128 + wn * 64 + c4 * 4;
        const float rs = rsqrtf(p_ssq2[m] * (1.f / 1024.f) + EPS);
        *(uint2*)(Qb + (size_t)m * 2048 + n) = pack4v(v * rs);
      });
    if (!more) break;
    it = itn;
  }
}

__device__ void ph_gemm4(const P& p, u16* lds) {
  const int lane = tid_() & 63, wid = tid_() >> 6, wm = wid >> 1, wn = wid & 1, fq = lane >> 4;
  const int NT = 8, NTILES = 264 * NT;
  int it = blockIdx.x;
  if (it >= NTILES) return;
  auto opsP = [&](int t) __attribute__((always_inline)) { return gemm_ops(p_Pb + (size_t)(t / NT) * 128 * 256, 256, p_WpT + (size_t)(t % NT) * 128 * 256, 256); };
  auto opsG = [&](int t) __attribute__((always_inline)) { return gemm_ops(p_Abf + (size_t)(t / NT) * 128 * DM, DM, p_WgT + (size_t)(t % NT) * 128 * DM, DM); };
  GemmOps g = opsP(it);
  __syncthreads();
  gemm_prologue(g, lds);
  while (true) {
    const int mt = it / NT, nt = it % NT;
    f32x4 acc[4][4]; ZERO_ACC(acc);
    gemm_main<false>(acc, g, 256, lds);
    __syncthreads();
    g = opsG(it);
    gemm_prologue(g, lds);
    uint2 pp[4][4];
#pragma unroll
    for (int i = 0; i < 4; ++i)
#pragma unroll
      for (int j = 0; j < 4; ++j) pp[i][j] = pack4v(acc[i][j]);
    ZERO_ACC(acc);
    gemm_main<false>(acc, g, DM, lds);
    const int itn = it + gridDim.x; const bool more = itn < NTILES;
    __syncthreads();
    if (more) { g = opsP(itn); gemm_prologue(g, lds); }
    float rs[4][4];
#pragma unroll
    for (int i = 0; i < 4; ++i)
#pragma unroll
      for (int r = 0; r < 4; ++r) rs[i][r] = rsqrtf(p_ssq[mt * 128 + wm * 64 + i * 16 + fq * 4 + r] * (1.f / 1024.f) + EPS);
    gemm_epilogue(acc, lds,
      [&](int i, int j, int r, float v) {
        const unsigned gw = (r < 2) ? pp[i][j].x : pp[i][j].y;
        const float pv = (r & 1) ? bfhi(gw) : bflo(gw);
        return pv * sigmoidf(v * rs[i][r]);
      },
      [&](int rowl, int c4, f32x4 v) {
        const int m = mt * 128 + wm * 64 + rowl, n = nt * 128 + wn * 64 + c4 * 4;
        uint2* o = (uint2*)(p_h16 + (size_t)m * DM + n);
        const uint2 hb = *o;
        const f32x4 hn = f32x4{bflo(hb.x), bfhi(hb.x), bflo(hb.y), bfhi(hb.y)} + v;
        *o = pack4v(hn);
      });
    if (!more) break;
    it = itn;
  }
}

#define LS 68
__device__ __forceinline__ bf16x8 ldsfrag8(const float* buf, int row, int col) {
  const float4 a = *(const float4*)(buf + row * LS + col), b = *(const float4*)(buf + row * LS + col + 4);
  return pack8(a.x, a.y, a.z, a.w, b.x, b.y, b.z, b.w);
}

__device__ void ph_dnpre(const P& p, float* lds) {
  const int tid = tid_(), lane = tid & 63, w = tid >> 6, fr = lane & 15, fq = lane >> 4;
  float* B0 = lds; float* B1 = lds + 64 * LS; float* B2 = lds + 2 * 64 * LS;
  float* sG = lds + 3 * 64 * LS;
  float* sBeta = sG + 64;
  float* sEG = sG + 128;
  u16* DNW = (u16*)p.out;
  u16* DNQH = DNW + (size_t)4096 * 4096;
  u16* DNQK = DNQH + (size_t)4096 * 4096;
  u16* DNKT = DNQK + (size_t)4096 * 4096;
  float* Ubuf = (float*)p_Abf;
  u16 xn[3][19]; u16 arn = 0, brn = 0;
  auto load_raw = [&](int chunk) __attribute__((always_inline)) {
    const int n = chunk & 127, h = (chunk >> 7) & 7, b = chunk >> 10;
    const size_t tok0 = (size_t)b * 8192 + n * 64;
    const bool has_prev = (n * 64 + w * 16) >= 3;
#pragma unroll
    for (int arr = 0; arr < 3; ++arr) {
      const u16* src = p_proj + 768 + arr * 512 + h * 64 + lane;
#pragma unroll
      for (int i = 0; i < 19; ++i) {
        const long row = (long)tok0 + w * 16 + i - 3;
        xn[arr][i] = (i >= 3 || has_prev) ? src[row * INW] : (u16)0;
      }
    }
    if (w == 0) {
      arn = p_proj[(tok0 + lane) * INW + 2816 + h];
      brn = p_proj[(tok0 + lane) * INW + 2824 + h];
    }
  };
  if ((int)blockIdx.x < 4096) load_raw(blockIdx.x);
  for (int chunk = blockIdx.x; chunk < 4096; chunk += gridDim.x) {
    const int n = chunk & 127, h = (chunk >> 7) & 7, b = chunk >> 10;
    const size_t tok0 = (size_t)b * 8192 + n * 64;
    __syncthreads();
    {
      u16 xr[3][19];
#pragma unroll
      for (int arr = 0; arr < 3; ++arr)
#pragma unroll
        for (int i = 0; i < 19; ++i) xr[arr][i] = xn[arr][i];
      const float ar_raw = bf2f(arn), br_raw = bf2f(brn);
      if (chunk + (int)gridDim.x < 4096) load_raw(chunk + gridDim.x);
#pragma unroll
      for (int arr = 0; arr < 3; ++arr) {
        const int ch = arr * 512 + h * 64 + lane;
        const float w0 = p.conv_w[ch], w1 = p.conv_w[1536 + ch], w2 = p.conv_w[3072 + ch], w3 = p.conv_w[4608 + ch];
        float* dst = arr == 0 ? B0 : (arr == 1 ? B1 : B2);
#pragma unroll
        for (int i = 0; i < 16; ++i) {
          float y = silu(w0 * bf2f(xr[arr][i]) + w1 * bf2f(xr[arr][i + 1]) + w2 * bf2f(xr[arr][i + 2]) + w3 * bf2f(xr[arr][i + 3]));
          if (arr < 2) {
            float ss = wave_sum(y * y);
            y *= rsqrtf(ss + EPS) * (arr == 0 ? 0.125f : 1.f);
          }
          dst[(w * 16 + i) * LS + lane] = y;
        }
      }
      if (w == 0) {
        float g = -__expf(p.a_log[h]) * softplusf(ar_raw + p.dt_bias[h]);
#pragma unroll
        for (int o = 1; o < 64; o <<= 1) {
          float t = __shfl_up(g, o);
          if (lane >= o) g += t;
        }
        sG[lane] = g;
        sBeta[lane] = sigmoidf(br_raw);
        sEG[lane] = __expf(g);
      }
    }
    __syncthreads();
    const float glast = sG[63];
    f32x4 kk[4];
    {
      bf16x8 qB[2], kB[2];
#pragma unroll
      for (int ks = 0; ks < 2; ++ks) { qB[ks] = ldsfrag8(B0, w * 16 + fr, ks * 32 + fq * 8); kB[ks] = ldsfrag8(B1, w * 16 + fr, ks * 32 + fq * 8); }
      f32x4 qk[4];
      const int ci = w * 16 + fr;
      const float Gc = sG[ci];
#pragma unroll
      for (int mt = 0; mt < 4; ++mt) {
        bf16x8 kA0 = ldsfrag8(B1, mt * 16 + fr, fq * 8), kA1 = ldsfrag8(B1, mt * 16 + fr, 32 + fq * 8);
        f32x4 z = {0.f, 0.f, 0.f, 0.f};
        qk[mt] = mfma16(kA0, qB[0], z); qk[mt] = mfma16(kA1, qB[1], qk[mt]);
        kk[mt] = mfma16(kA0, kB[0], z); kk[mt] = mfma16(kA1, kB[1], kk[mt]);
#pragma unroll
        for (int r = 0; r < 4; ++r) {
          int rw = mt * 16 + fq * 4 + r;
          float Gr = sG[rw];
          qk[mt][r] = (ci >= rw) ? qk[mt][r] * __expf(Gc - Gr) : 0.f;
          kk[mt][r] = (rw > ci) ? kk[mt][r] * sBeta[rw] * __expf(Gr - Gc) : 0.f;
        }
      }
#pragma unroll
      for (int kb = 0; kb < 2; ++kb)
        *(bf16x8*)(DNQK + (size_t)chunk * 4096 + ((w * 2 + kb) * 64 + lane) * 8) = pack8v(qk[2 * kb], qk[2 * kb + 1]);
      {
        const float eg = __expf(sG[w * 16 + fr]);
#pragma unroll
        for (int kb = 0; kb < 2; ++kb) {
          const float4 a = *(const float4*)(B0 + (w * 16 + fr) * LS + kb * 32 + fq * 4);
          const float4 c = *(const float4*)(B0 + (w * 16 + fr) * LS + kb * 32 + 16 + fq * 4);
          *(bf16x8*)(DNQH + (size_t)chunk * 4096 + ((w * 2 + kb) * 64 + lane) * 8) =
              pack8(a.x * eg, a.y * eg, a.z * eg, a.w * eg, c.x * eg, c.y * eg, c.z * eg, c.w * eg);
        }
      }
      {
        const int d = w * 16 + fr;
#pragma unroll
        for (int kb = 0; kb < 2; ++kb) {
          float v[8];
#pragma unroll
          for (int e = 0; e < 8; ++e) {
            int tk = kb * 32 + (e >> 2) * 16 + fq * 4 + (e & 3);
            v[e] = B1[tk * LS + d] * __expf(glast - sG[tk]);
          }
          *(bf16x8*)(DNKT + (size_t)chunk * 4096 + ((w * 2 + kb) * 64 + lane) * 8) = pack8(v[0], v[1], v[2], v[3], v[4], v[5], v[6], v[7]);
        }
      }
    }
    __syncthreads();
#pragma unroll
    for (int mt = 0; mt < 4; ++mt)
#pragma unroll
      for (int r = 0; r < 4; ++r) {
        const int j = w * 16 + fr;
        B0[(j & 1) * 2048 + (mt * 16 + fq * 4 + r) * 32 + (j >> 1)] = kk[mt][r];
      }
    __syncthreads();
    {
      const int c = tid >> 1, par = tid & 1;
      float xe[32];
      float* col = c < 64 ? (B2 + c) : (B1 + c - 64);
      const float* Lp = B0 + par * 2048;
#pragma unroll
      for (int i = 0; i < 64; ++i) {
        float sc = sBeta[i];
        if (c >= 64) sc *= sEG[i];
        const float rhs = col[i * LS] * sc;
        float a0 = 0.f, a1 = 0.f;
#pragma unroll
        for (int jj = 0; 2 * jj + 1 < i; ++jj) {
          const float l = Lp[i * 32 + jj];
          if (jj & 1) a1 += l * xe[jj]; else a0 += l * xe[jj];
        }
        if (i & 1) {
          const float l = B0[i * 32 + (i >> 1)];
          a0 += (par == 0) ? l * xe[i >> 1] : 0.f;
        }
        float acc = a0 + a1;
        acc += dpp_f<DPP_XOR1>(acc);
        const float xi = rhs - acc;
        if ((i & 1) == 0) xe[i >> 1] = xi;
        else xe[i >> 1] = (par == 1) ? xi : xe[i >> 1];
      }
#pragma unroll
      for (int jj = 0; jj < 32; ++jj) col[(2 * jj + par) * LS] = xe[jj];
    }
    __syncthreads();
#pragma unroll
    for (int kb = 0; kb < 2; ++kb) {
      const float4 a = *(const float4*)(B1 + (w * 16 + fr) * LS + kb * 32 + fq * 4);
      const float4 c = *(const float4*)(B1 + (w * 16 + fr) * LS + kb * 32 + 16 + fq * 4);
      *(bf16x8*)(DNW + (size_t)chunk * 4096 + ((w * 2 + kb) * 64 + lane) * 8) = pack8(a.x, a.y, a.z, a.w, c.x, c.y, c.z, c.w);
    }
#pragma unroll
    for (int nt = 0; nt < 4; ++nt) {
      f32x4 u;
#pragma unroll
      for (int r = 0; r < 4; ++r) u[r] = B2[(w * 16 + fq * 4 + r) * LS + nt * 16 + fr];
      *(f32x4*)(Ubuf + (size_t)chunk * 4096 + ((w * 4 + nt) * 64 + lane) * 4) = u;
    }
    if (tid == 0) p_gl[chunk] = __expf(glast);
  }
}

struct ScanCtx {
  const u16 *DNW, *DNQH, *DNQK, *DNKT;
  const float* Ubuf; float* Obuf; const float* glp; u16* Vbuf;
  int seq, w, lane;
};
__device__ __forceinline__ void scan_load(const ScanCtx& c, int n, bf16x8 (&W_)[2], bf16x8 (&QH_)[2], bf16x8 (&QK_)[2],
                                          bf16x8 (&KT_)[2], f32x4 (&U_)[4], float& g_) {
  n = n < 128 ? n : 127;
  const size_t cb = (size_t)(c.seq * 128 + n) * 4096;
#pragma unroll
  for (int kb = 0; kb < 2; ++kb) {
    const size_t o = cb + ((c.w * 2 + kb) * 64 + c.lane) * 8;
    W_[kb] = *(const bf16x8*)(c.DNW + o); QH_[kb] = *(const bf16x8*)(c.DNQH + o); QK_[kb] = *(const bf16x8*)(c.DNQK + o); KT_[kb] = *(const bf16x8*)(c.DNKT + o);
  }
#pragma unroll
  for (int nt = 0; nt < 4; ++nt) U_[nt] = *(const f32x4*)(c.Ubuf + cb + ((c.w * 4 + nt) * 64 + c.lane) * 4);
  g_ = c.glp[c.seq * 128 + n];
}
__device__ __forceinline__ void scan_step(const ScanCtx& c, int n, const u16* Sc, u16* Sn, f32x4 (&S)[4], bf16x8 (&W_)[2],
                                          bf16x8 (&QH_)[2], bf16x8 (&QK_)[2], bf16x8 (&KT_)[2], f32x4 (&U_)[4], float& g_,
                                          unsigned (&tr)[7]) {
  const int w = c.w, lane = c.lane;
  const size_t cb = (size_t)(c.seq * 128 + n) * 4096;
  bf16x8 Sf[2][4];
#pragma unroll
  for (int kb = 0; kb < 2; ++kb)
#pragma unroll
    for (int nt = 0; nt < 4; ++nt) Sf[kb][nt] = *(const bf16x8*)(Sc + ((kb * 4 + nt) * 64 + lane) * 8);
#pragma unroll
  for (int nt = 0; nt < 4; ++nt) {
    f32x4 a = {0.f, 0.f, 0.f, 0.f};
    a = mfma16(W_[0], Sf[0][nt], a); a = mfma16(W_[1], Sf[1][nt], a);
    f32x4 vn = U_[nt] - a;
    *(uint2*)(c.Vbuf + (((w >> 1) * 4 + nt) * 64 + lane) * 8 + (w & 1) * 4) = pack4v(vn);
  }
  __syncthreads();
  bf16x8 Vf[2][4];
#pragma unroll
  for (int kb = 0; kb < 2; ++kb)
#pragma unroll
    for (int nt = 0; nt < 4; ++nt) Vf[kb][nt] = *(const bf16x8*)(c.Vbuf + ((kb * 4 + nt) * 64 + lane) * 8);
  const float glc = g_;
#pragma unroll
  for (int nt = 0; nt < 4; ++nt) {
    f32x4 o = {0.f, 0.f, 0.f, 0.f};
    o = mfma16(QH_[0], Sf[0][nt], o); o = mfma16(QH_[1], Sf[1][nt], o);
    o = mfma16(QK_[0], Vf[0][nt], o); o = mfma16(QK_[1], Vf[1][nt], o);
    *(f32x4*)(c.Obuf + cb + ((w * 4 + nt) * 64 + lane) * 4) = o;
    f32x4 sv = S[nt] * glc;
    sv = mfma16(KT_[0], Vf[0][nt], sv); sv = mfma16(KT_[1], Vf[1][nt], sv);
    S[nt] = sv;
    *(uint2*)(Sn + (((w >> 1) * 4 + nt) * 64 + lane) * 8 + (w & 1) * 4) = pack4v(sv);
  }
  __builtin_amdgcn_sched_barrier(0);
  scan_load(c, n + 2, W_, QH_, QK_, KT_, U_, g_);
  {
    tr[0] ^= tr[1] ^ tr[4];
    tr[1] = tr[2]; tr[4] = tr[5]; tr[2] = tr[3]; tr[5] = tr[6];
    const size_t pb = (size_t)(c.seq * 128 + (n + 5 < 128 ? n + 5 : 127)) * 4096;
    const u16* arr4 = (lane >> 4) == 0 ? c.DNW : ((lane >> 4) == 1 ? c.DNQH : ((lane >> 4) == 2 ? c.DNQK : c.DNKT));
    tr[3] = *(const unsigned*)(arr4 + pb + w * 1024 + (lane & 15) * 64);
    tr[6] = *(const unsigned*)(c.Ubuf + pb + w * 1024 + (lane & 31) * 32);
  }
  __syncthreads();
}

__device__ void scan_seq(const P& p, int seq, u16* lds) {
  const int tid = tid_(), lane = tid & 63, w = tid >> 6, fr = lane & 15, fq = lane >> 4;
  u16* Sb0 = lds; u16* Sb1 = lds + 4096;
  ScanCtx c;
  c.DNW = (const u16*)p.out;
  c.DNQH = c.DNW + (size_t)4096 * 4096;
  c.DNQK = c.DNQH + (size_t)4096 * 4096;
  c.DNKT = c.DNQK + (size_t)4096 * 4096;
  c.Ubuf = (const float*)p_Abf; c.Obuf = p_Obuf; c.glp = p_gl; c.Vbuf = lds + 8192;
  c.seq = seq; c.w = w; c.lane = lane;
  __syncthreads();
  for (int i = tid; i < 4096 / 2; i += 256) ((unsigned*)Sb0)[i] = 0u;
  f32x4 S[4];
#pragma unroll
  for (int nt = 0; nt < 4; ++nt) S[nt] = f32x4{0.f, 0.f, 0.f, 0.f};
  bf16x8 Wa[2], QHa[2], QKa[2], KTa[2]; f32x4 Ua[4]; float ga;
  bf16x8 Wb[2], QHb[2], QKb[2], KTb[2]; f32x4 Ub[4]; float gb;
  unsigned tr[7] = {0u, 0u, 0u, 0u, 0u, 0u, 0u};
  scan_load(c, 0, Wa, QHa, QKa, KTa, Ua, ga);
  scan_load(c, 1, Wb, QHb, QKb, KTb, Ub, gb);
  __syncthreads();
#pragma unroll 1
  for (int n = 0; n < 128; n += 2) {
    scan_step(c, n, Sb0, Sb1, S, Wa, QHa, QKa, KTa, Ua, ga, tr);
    scan_step(c, n + 1, Sb1, Sb0, S, Wb, QHb, QKb, KTb, Ub, gb, tr);
  }
  if ((tr[0] ^ tr[1] ^ tr[2] ^ tr[3] ^ tr[4] ^ tr[5] ^ tr[6]) == 0x9e3779b9u && seq == 4097) p_gl[0] = 0.f;
#pragma unroll
  for (int nt = 0; nt < 4; ++nt)
#pragma unroll
    for (int r = 0; r < 4; ++r) p.out[O_DP + ((size_t)seq * 64 + w * 16 + fq * 4 + r) * 64 + nt * 16 + fr] = S[nt][r];
}

#define VS 280
template <int NQ, typename KL>
__device__ __forceinline__ void attn_core(const bf16x8 (&qf)[NQ][2], KL kload, const u16* vT, const float (&slope)[NQ],
                                          const float (&sink)[NQ], const int (&ql)[NQ], int jmin, f32x4 (&o)[4][NQ]) {
  const int lane = tid_() & 63, fr = lane & 15, fq = lane >> 4;
  f32x4 s[10][NQ];
#pragma unroll
  for (int mt = 0; mt < 10; ++mt) {
    bf16x8 k0 = kload(mt, 0), k1 = kload(mt, 1);
#pragma unroll
    for (int nq = 0; nq < NQ; ++nq) {
      f32x4 z = {0.f, 0.f, 0.f, 0.f};
      z = mfma16(k0, qf[nq][0], z);
      s[mt][nq] = mfma16(k1, qf[nq][1], z);
    }
  }
#pragma unroll
  for (int nq = 0; nq < NQ; ++nq) {
    float m = sink[nq];
#pragma unroll
    for (int mt = 0; mt < 10; ++mt)
#pragma unroll
      for (int r = 0; r < 4; ++r) {
        int jl = mt * 16 + fq * 4 + r;
        bool valid = (jl >= ql[nq]) && (jl <= ql[nq] + 128) && (jl >= jmin);
        float dist = (float)(128 + ql[nq] - jl);
        float v = valid ? s[mt][nq][r] * 0.125f - slope[nq] * dist : -1e30f;
        s[mt][nq][r] = v;
        m = fmaxf(m, v);
      }
    m = fmaxf(m, __shfl_xor(m, 16)); m = fmaxf(m, __shfl_xor(m, 32));
    float sum = 0.f;
#pragma unroll
    for (int mt = 0; mt < 10; ++mt)
#pragma unroll
      for (int r = 0; r < 4; ++r) { float e = __expf(s[mt][nq][r] - m); s[mt][nq][r] = e; sum += e; }
    sum += __shfl_xor(sum, 16); sum += __shfl_xor(sum, 32);
    float inv = 1.f / (sum + __expf(sink[nq] - m));
#pragma unroll
    for (int mt = 0; mt < 10; ++mt) s[mt][nq] = s[mt][nq] * inv;
  }
#pragma unroll
  for (int mt = 0; mt < 4; ++mt)
#pragma unroll
    for (int nq = 0; nq < NQ; ++nq) o[mt][nq] = f32x4{0.f, 0.f, 0.f, 0.f};
#pragma unroll
  for (int kb = 0; kb < 5; ++kb) {
    bf16x8 pf[NQ];
#pragma unroll
    for (int nq = 0; nq < NQ; ++nq) pf[nq] = pack8v(s[2 * kb][nq], s[2 * kb + 1][nq]);
#pragma unroll
    for (int mt = 0; mt < 4; ++mt) {
      const u16* vr = vT + (mt * 16 + fr) * VS + kb * 32 + fq * 4;
      BF8 vf; uint2 a = *(const uint2*)vr, c = *(const uint2*)(vr + 16);
      vf.u[0] = a.x; vf.u[1] = a.y; vf.u[2] = c.x; vf.u[3] = c.y;
#pragma unroll
      for (int nq = 0; nq < NQ; ++nq) o[mt][nq] = mfma16(vf.v, pf[nq], o[mt][nq]);
    }
  }
}

__device__ void attn_prompt_item(const P& p, int item, u16* vT) {
  const int tid = tid_(), lane = tid & 63, w = tid >> 6, fr = lane & 15, fq = lane >> 4;
  const int head = item & 7, n = (item >> 3) & 63, b = item >> 9, kvh = head >> 2;
  __syncthreads();
#pragma unroll
  for (int i = 0; i < 8; ++i) {
    int id = tid + i * 256, j = id >> 3, c = id & 7;
    int pos = (n - 1) * 128 + j;
    BF8 t; t.q = make_uint4(0, 0, 0, 0);
    if (pos >= 0) t.q = *(const uint4*)(p_proj + ((size_t)b * 8192 + pos) * INW + 640 + kvh * 64 + c * 8);
#pragma unroll
    for (int e = 0; e < 8; ++e) vT[(c * 8 + e) * VS + j] = (u16)(t.u[e >> 1] >> ((e & 1) * 16));
  }
  if (tid < 64) {
#pragma unroll
    for (int e = 0; e < 24; ++e) vT[tid * VS + 256 + e] = 0;
  }
  __syncthreads();
#pragma unroll 1
  for (int nq = 0; nq < 2; ++nq) {
    const int i0 = w * 32 + nq * 16;
    const size_t tokb = (size_t)b * 8192 + n * 128 + i0;
    bf16x8 qf[1][2];
#pragma unroll
    for (int ks = 0; ks < 2; ++ks) qf[0][ks] = *(const bf16x8*)(p_proj + (tokb + fr) * INW + head * 64 + ks * 32 + fq * 8);
    auto kload = [&](int mt, int ks) -> bf16x8 {
      int pos = (n - 1) * 128 + i0 + mt * 16 + fr;
      pos = pos < 0 ? 0 : pos;
      pos = pos > n * 128 + 127 ? n * 128 + 127 : pos;
      return *(const bf16x8*)(p_proj + ((size_t)b * 8192 + pos) * INW + 512 + kvh * 64 + ks * 32 + fq * 8);
    };
    float slope[1], sink[1]; int ql[1];
    slope[0] = exp2f(-(float)(head + 1));
    sink[0] = p.sinks[head];
    ql[0] = fr;
    const int jmin = (n == 0) ? 128 - i0 : 0;
    f32x4 o[4][1];
    attn_core<1>(qf, kload, vT + i0, slope, sink, ql, jmin, o);
#pragma unroll
    for (int mt = 0; mt < 4; ++mt)
      *(uint2*)(p_mix + (tokb + fr) * DM + head * 64 + mt * 16 + fq * 4) = pack4v(o[mt][0]);
  }
}

__device__ void attn_sample_item(const P& p, int item, u16* vT) {
  const int tid = tid_(), lane = tid & 63, w = tid >> 6, fr = lane & 15, fq = lane >> 4;
  const int kvh = item & 1, b = item >> 1;
  __syncthreads();
  for (int id = tid; id < 168 * 8; id += 256) {
    int j = id >> 3, c = id & 7;
    BF8 t; t.q = make_uint4(0, 0, 0, 0);
    if (j < 128) {
      const float* s = p.cv + (((size_t)b * 128 + j) * 2 + kvh) * 64 + c * 8;
      float4 a = *(const float4*)s, d = *(const float4*)(s + 4);
      t.u[0] = pack2(a.x, a.y); t.u[1] = pack2(a.z, a.w); t.u[2] = pack2(d.x, d.y); t.u[3] = pack2(d.z, d.w);
    } else if (j < 136) {
      t.q = *(const uint4*)(p_proj + ((size_t)TP + b * 8 + (j - 128)) * INW + 640 + kvh * 64 + c * 8);
    }
#pragma unroll
    for (int e = 0; e < 8; ++e) vT[(c * 8 + e) * VS + j] = (u16)(t.u[e >> 1] >> ((e & 1) * 16));
  }
  __syncthreads();
  if (w < 2) {
    const int r = w * 16 + fr, hq = kvh * 4 + (r >> 3), ti = r & 7;
    const size_t tok = (size_t)TP + b * 8 + ti;
    bf16x8 qf[1][2];
#pragma unroll
    for (int ks = 0; ks < 2; ++ks) qf[0][ks] = *(const bf16x8*)(p_proj + tok * INW + hq * 64 + ks * 32 + fq * 8);
    auto kload = [&](int mt, int ks) -> bf16x8 {
      int jl = mt * 16 + fr;
      if (jl < 128) {
        const float* s = p.ck + (((size_t)b * 128 + jl) * 2 + kvh) * 64 + ks * 32 + fq * 8;
        float4 a = *(const float4*)s, d = *(const float4*)(s + 4);
        return pack8(a.x, a.y, a.z, a.w, d.x, d.y, d.z, d.w);
      }
      int t = jl - 128; t = t > 7 ? 7 : t;
      return *(const bf16x8*)(p_proj + ((size_t)TP + b * 8 + t) * INW + 512 + kvh * 64 + ks * 32 + fq * 8);
    };
    float slope[1], sink[1]; int ql[1];
    slope[0] = exp2f(-(float)(hq + 1)); sink[0] = p.sinks[hq]; ql[0] = ti;
    f32x4 o[4][1];
    attn_core<1>(qf, kload, vT, slope, sink, ql, 0, o);
#pragma unroll
    for (int mt = 0; mt < 4; ++mt) *(uint2*)(p_mix + tok * DM + hq * 64 + mt * 16 + fq * 4) = pack4v(o[mt][0]);
  }
}

__device__ void dn_sample_wave(const P& p, int bh) {
  const int lane = tid_() & 63;
  const int h = bh & 7, b = bh >> 3;
  float cw[3][4], xs[3][3];
#pragma unroll
  for (int arr = 0; arr < 3; ++arr) {
    const int ch = arr * 512 + h * 64 + lane;
#pragma unroll
    for (int j = 0; j < 4; ++j) cw[arr][j] = p.conv_w[j * 1536 + ch];
#pragma unroll
    for (int j = 0; j < 3; ++j) xs[arr][j] = p.sconv[((size_t)b * 3 + j) * 1536 + ch];
  }
  float S[64];
  const float* s0 = p.sdelta + (size_t)bh * 4096 + lane;
#pragma unroll
  for (int d = 0; d < 64; ++d) S[d] = s0[d * 64];
  const float eA = __expf(p.a_log[h]), dtb = p.dt_bias[h], gn = p.dn_norm[lane];
  u16 nx[3], nar, nbr, nz;
  {
    const size_t tok = (size_t)TP + b * 8;
#pragma unroll
    for (int arr = 0; arr < 3; ++arr) nx[arr] = p_proj[tok * INW + 768 + arr * 512 + h * 64 + lane];
    nar = p_proj[tok * INW + 2816 + h]; nbr = p_proj[tok * INW + 2824 + h]; nz = p_proj[tok * INW + 2304 + h * 64 + lane];
  }
#pragma unroll 1
  for (int t = 0; t < 8; ++t) {
    const size_t tok = (size_t)TP + b * 8 + t;
    const u16 cx0 = nx[0], cx1 = nx[1], cx2 = nx[2], car = nar, cbr = nbr, cz = nz;
    {
      const size_t tn = (size_t)TP + b * 8 + (t < 7 ? t + 1 : 7);
#pragma unroll
      for (int arr = 0; arr < 3; ++arr) nx[arr] = p_proj[tn * INW + 768 + arr * 512 + h * 64 + lane];
      nar = p_proj[tn * INW + 2816 + h]; nbr = p_proj[tn * INW + 2824 + h]; nz = p_proj[tn * INW + 2304 + h * 64 + lane];
    }
    float y[3];
#pragma unroll
    for (int arr = 0; arr < 3; ++arr) {
      float x3 = bf2f(arr == 0 ? cx0 : (arr == 1 ? cx1 : cx2));
      y[arr] = silu(cw[arr][0] * xs[arr][0] + cw[arr][1] * xs[arr][1] + cw[arr][2] * xs[arr][2] + cw[arr][3] * x3);
      xs[arr][0] = xs[arr][1]; xs[arr][1] = xs[arr][2]; xs[arr][2] = x3;
    }
    const float qv = y[0] * rsqrtf(wave_sum(y[0] * y[0]) + EPS) * 0.125f;
    const float kv = y[1] * rsqrtf(wave_sum(y[1] * y[1]) + EPS);
    const float vv = y[2];
    float ar = bf2f(car), br = bf2f(cbr);
    float a = __expf(-eA * softplusf(ar + dtb));
    float beta = sigmoidf(br);
    float kS = 0.f;
#pragma unroll
    for (int d = 0; d < 64; ++d) kS += __int_as_float(__builtin_amdgcn_readlane(__float_as_int(kv), d)) * S[d];
    float vn = beta * (vv - a * kS);
    float o = 0.f;
#pragma unroll
    for (int d = 0; d < 64; ++d) {
      float kd = __int_as_float(__builtin_amdgcn_readlane(__float_as_int(kv), d));
      float qd = __int_as_float(__builtin_amdgcn_readlane(__float_as_int(qv), d));
      S[d] = a * S[d] + kd * vn;
      o += qd * S[d];
    }
    float ss = wave_sum(o * o);
    float rs = rsqrtf(ss * (1.f / 64.f) + EPS);
    float z = bf2f(cz);
    p_mix[tok * DM + 512 + h * 64 + lane] = f2bf(o * rs * gn * silu(z));
  }
  float* so = p.out + O_DS + (size_t)bh * 4096 + lane;
#pragma unroll
  for (int d = 0; d < 64; ++d) so[d * 64] = S[d];
}

__device__ void copy_item(const P& p, int item) {
  int e = item * 2048 + tid_();
#pragma unroll
  for (int k = 0; k < 8; ++k, e += 256) {
    int i = e;
    if (i < 131072) {
      int which = i >> 16; i &= 65535;
      int d = i & 63, kvh = (i >> 6) & 1, wpos = (i >> 7) & 127, b = i >> 14;
      float v = bf2f(p_proj[((size_t)b * 8192 + 8064 + wpos) * INW + 512 + which * 128 + kvh * 64 + d]);
      p.out[(which ? O_VP : O_KP) + i] = v;
    } else if ((i -= 131072) < 18432) {
      int c = i % 1536, j = (i / 1536) % 3, b = i / 4608;
      p.out[O_CP + i] = bf2f(p_proj[((size_t)b * 8192 + 8189 + j) * INW + 768 + c]);
    } else if ((i -= 18432) < 4194304) {
      int which = i >> 21; i &= 2097151;
      int d = i & 63, kvh = (i >> 6) & 1, wpos = (i >> 7) & 127, b = i >> 14;
      float v;
      if (wpos < 120) v = (which ? p.cv : p.ck)[(((size_t)b * 128 + wpos + 8) * 2 + kvh) * 64 + d];
      else v = bf2f(p_proj[((size_t)TP + b * 8 + wpos - 120) * INW + 512 + which * 128 + kvh * 64 + d]);
      p.out[(which ? O_VS : O_KS) + i] = v;
    } else {
      i -= 4194304;
      int c = i % 1536, j = (i / 1536) % 3, b = i / 4608;
      p.out[O_CS + i] = bf2f(p_proj[((size_t)TP + b * 8 + 5 + j) * INW + 768 + c]);
    }
  }
}

__device__ void ph_mixer(const P& p, u16* lds) {
  const int NSCAN = 32;
#ifndef MIXMASK
#define MIXMASK 31
#endif
  if ((int)blockIdx.x < NSCAN) { if (MIXMASK & 1) scan_seq(p, blockIdx.x, lds); return; }
  const int NA = 2048, NSA = 256, NSD = 256, NCP = 2409;
  const int st = gridDim.x - NSCAN, b0 = blockIdx.x - NSCAN;
  auto first = [&](int off) { int f = b0 - (off % st); return f < 0 ? f + st : f; };
  if (MIXMASK & 8) for (int it = first(0); it < NSD; it += st) dn_sample_wave(p, it * 4 + (tid_() >> 6));
  if (MIXMASK & 4) for (int it = first(224); it < NSA; it += st) attn_sample_item(p, it, lds);
  if (MIXMASK & 2) for (int it = first(288); it < NA; it += st) attn_prompt_item(p, it, lds);
  if (MIXMASK & 16) for (int it = first(256); it < NCP; it += st) copy_item(p, it);
}

__device__ void ph_gatenorm(const P& p) {
  const int lane = tid_() & 63, w = tid_() >> 6, fr = lane & 15, fq = lane >> 4;
  const float* Ubuf = (const float*)p_Obuf;
  for (int chunk = blockIdx.x; chunk < 4096; chunk += gridDim.x) {
    const int n = chunk & 127, h = (chunk >> 7) & 7, b = chunk >> 10;
    f32x4 o[4];
    float ss[4] = {0.f, 0.f, 0.f, 0.f};
#pragma unroll
    for (int nt = 0; nt < 4; ++nt) {
      o[nt] = *(const f32x4*)(Ubuf + (size_t)chunk * 4096 + ((w * 4 + nt) * 64 + lane) * 4);
#pragma unroll
      for (int r = 0; r < 4; ++r) ss[r] += o[nt][r] * o[nt][r];
    }
#pragma unroll
    for (int r = 0; r < 4; ++r) {
      float s = ss[r];
      s += __shfl_xor(s, 1); s += __shfl_xor(s, 2); s += __shfl_xor(s, 4); s += __shfl_xor(s, 8);
      ss[r] = rsqrtf(s * (1.f / 64.f) + EPS);
    }
#pragma unroll
    for (int nt = 0; nt < 4; ++nt) {
      const float gn = p.dn_norm[nt * 16 + fr];
#pragma unroll
      for (int r = 0; r < 4; ++r) {
        size_t tok = (size_t)b * 8192 + n * 64 + w * 16 + fq * 4 + r;
        float z = bf2f(p_proj[tok * INW + 2304 + h * 64 + nt * 16 + fr]);
        p_mix[tok * DM + 512 + h * 64 + nt * 16 + fr] = f2bf(o[nt][r] * ss[r] * gn * silu(z));
      }
    }
  }
}

__device__ void ph_norm_ffn(const P& p) {
  const int lane = tid_() & 63, wid = tid_() >> 6;
  for (int it = blockIdx.x; it < TT / 16; it += gridDim.x) {
    int t0 = it * 16 + wid * 4;
    rms_rows<4>([&](int t) { return (const float*)(p.out + (size_t)t * DM); }, p.norm_ffn, p_Abf, t0, lane);
  }
}
__device__ void ph_final(const P& p) {
  const int lane = tid_() & 63, wid = tid_() >> 6;
  f32x4 g[4];
#pragma unroll
  for (int i = 0; i < 4; ++i) g[i] = *(const f32x4*)(p.norm_final + i * 256 + lane * 4);
  for (int it = blockIdx.x; it < TT / 16; it += gridDim.x) {
    const int t0 = it * 16 + wid * 4;
    uint2 hb[4][4];
#pragma unroll
    for (int r = 0; r < 4; ++r)
#pragma unroll
      for (int i = 0; i < 4; ++i) hb[r][i] = *(const uint2*)(p_h16 + (size_t)(t0 + r) * DM + i * 256 + lane * 4);
#pragma unroll
    for (int r = 0; r < 4; ++r) {
      f32x4 v[4];
      float ss = 0.f;
#pragma unroll
      for (int i = 0; i < 4; ++i) {
        v[i] = f32x4{bflo(hb[r][i].x), bfhi(hb[r][i].x), bflo(hb[r][i].y), bfhi(hb[r][i].y)};
        ss += v[i][0] * v[i][0] + v[i][1] * v[i][1] + v[i][2] * v[i][2] + v[i][3] * v[i][3];
      }
      ss = wave_sum(ss);
      const float rs = rsqrtf(ss * (1.f / 1024.f) + EPS);
#pragma unroll
      for (int i = 0; i < 4; ++i) *(f32x4*)(p.out + (size_t)(t0 + r) * DM + i * 256 + lane * 4) = v[i] * rs * g[i];
    }
  }
}

#define CE1(a, b) { int hi_ = max((a), (b)), lo_ = min((a), (b)); (a) = hi_; (b) = lo_; }
__device__ __forceinline__ int key_pack(float v, int payload, int mask) {
  int b = (__float_as_int(v) & ~mask) | payload;
  return b ^ ((b >> 31) & 0x7fffffff);
}
__device__ __forceinline__ int key_unmap(int k) { return k ^ ((k >> 31) & 0x7fffffff); }
__device__ __forceinline__ void sort16p(int (&v)[16]) {
#pragma unroll
  for (int k = 2; k <= 16; k <<= 1)
#pragma unroll
    for (int j = k >> 1; j > 0; j >>= 1)
#pragma unroll
      for (int i = 0; i < 16; ++i) {
        int l = i ^ j;
        if (l > i) {
          if ((i & k) == 0) { CE1(v[i], v[l]); }
          else { CE1(v[l], v[i]); }
        }
      }
}
__device__ __forceinline__ void merge16p(int (&a)[16], const int (&b)[16]) {
#pragma unroll
  for (int i = 0; i < 16; ++i) a[i] = max(a[i], b[15 - i]);
#pragma unroll
  for (int j = 8; j > 0; j >>= 1)
#pragma unroll
    for (int i = 0; i < 16; ++i) {
      int l = i ^ j;
      if (l > i) { CE1(a[i], a[l]); }
    }
}
__device__ __forceinline__ void xmerge16p(int (&a)[16], int mask) {
  int b[16];
#pragma unroll
  for (int i = 0; i < 16; ++i) b[i] = (mask == 16) ? __builtin_amdgcn_ds_swizzle(a[i], 0x401F) : __shfl_xor(a[i], 32);
  merge16p(a, b);
}

__device__ void ph_score(const P& p, int* lds) {
  const int lane = tid_() & 63, w = tid_() >> 6, fr = lane & 15, fq = lane >> 4;
  const u16* Qb = p_proj;
  int* experts = (int*)p_mix;
  float* gates = (float*)(p_mix) + (size_t)TT * 128;
  int* myl = lds + w * 512 + fr * 32;
  for (int it = blockIdx.x; it < 528 * 8; it += gridDim.x) {
    const int h = it & 7, tile = it >> 3;
    const size_t tok = (size_t)tile * 64 + w * 16 + fr;
    float tv[2][16];
#pragma unroll
    for (int half = 0; half < 2; ++half) {
      const u16* Kb = (half ? p_K2b : p_K1b) + h * 128 * 128;
      f32x4 sc[8];
#pragma unroll
      for (int mt = 0; mt < 8; ++mt) sc[mt] = f32x4{0.f, 0.f, 0.f, 0.f};
#pragma unroll
      for (int ks = 0; ks < 4; ++ks) {
        bf16x8 qf = *(const bf16x8*)(Qb + tok * 2048 + h * 256 + half * 128 + ks * 32 + fq * 8);
#pragma unroll
        for (int mt = 0; mt < 8; ++mt) {
          bf16x8 kf = *(const bf16x8*)(Kb + (mt * 16 + fr) * 128 + ks * 32 + fq * 8);
          sc[mt] = mfma16(kf, qf, sc[mt]);
        }
      }
      int a[16], b[16];
#pragma unroll
      for (int mt = 0; mt < 4; ++mt)
#pragma unroll
        for (int r = 0; r < 4; ++r) {
          a[mt * 4 + r] = key_pack(sc[mt][r], mt * 16 + fq * 4 + r, 0x7f);
          b[mt * 4 + r] = key_pack(sc[mt + 4][r], (mt + 4) * 16 + fq * 4 + r, 0x7f);
        }
      sort16p(a);
      __builtin_amdgcn_sched_barrier(0);
      sort16p(b);
      __builtin_amdgcn_sched_barrier(0);
      merge16p(a, b);
      xmerge16p(a, 16); xmerge16p(a, 32);
      __builtin_amdgcn_sched_barrier(0);
      int idx4[4];
#pragma unroll
      for (int i = 0; i < 16; ++i) {
        const int k = key_unmap(a[i]);
        tv[half][i] = __int_as_float(k & ~0x7f);
        if ((i >> 2) == 0) idx4[i & 3] = k & 0x7f;
      }
#pragma unroll
      for (int i = 4; i < 16; ++i) {
        const int k = key_unmap(a[i]) & 0x7f;
        if ((i >> 2) == 1) idx4[i & 3] = (fq == 1) ? k : idx4[i & 3];
        if ((i >> 2) == 2) idx4[i & 3] = (fq == 2) ? k : idx4[i & 3];
        if ((i >> 2) == 3) idx4[i & 3] = (fq == 3) ? k : idx4[i & 3];
      }
      *(int4*)(myl + half * 16 + fq * 4) = make_int4(idx4[0], idx4[1], idx4[2], idx4[3]);
    }
    int L0[16];
#pragma unroll
    for (int rr = 0; rr < 4; ++rr) {
      const float v1 = fq == 0 ? tv[0][rr] : (fq == 1 ? tv[0][4 + rr] : (fq == 2 ? tv[0][8 + rr] : tv[0][12 + rr]));
      int Lr[16];
#pragma unroll
      for (int j = 0; j < 16; ++j) Lr[j] = key_pack(v1 + tv[1][j], ((fq * 4 + rr) << 4) | j, 0xff);
      if (rr == 0) {
#pragma unroll
        for (int j = 0; j < 16; ++j) L0[j] = Lr[j];
      } else {
        merge16p(L0, Lr);
      }
      __builtin_amdgcn_sched_barrier(0);
    }
    xmerge16p(L0, 16); xmerge16p(L0, 32);
    float e[16], sum = 0.f; int ci[16];
    const float smax = __int_as_float(key_unmap(L0[0]) & ~0xff);
#pragma unroll
    for (int i = 0; i < 16; ++i) {
      const int k = key_unmap(L0[i]);
      ci[i] = k & 0xff;
      e[i] = __expf(__int_as_float(k & ~0xff) - smax);
      sum += e[i];
    }
    const float inv = 1.f / sum;
    int c4[4]; float g4[4];
#pragma unroll
    for (int rr = 0; rr < 4; ++rr) {
      c4[rr] = fq == 0 ? ci[rr] : (fq == 1 ? ci[4 + rr] : (fq == 2 ? ci[8 + rr] : ci[12 + rr]));
      g4[rr] = (fq == 0 ? e[rr] : (fq == 1 ? e[4 + rr] : (fq == 2 ? e[8 + rr] : e[12 + rr]))) * inv;
    }
    __builtin_amdgcn_s_waitcnt(0xc07f);
    __builtin_amdgcn_wave_barrier();
    int ex4[4];
#pragma unroll
    for (int rr = 0; rr < 4; ++rr) ex4[rr] = (myl[c4[rr] >> 4] << 7) | myl[16 + (c4[rr] & 15)];
    *(int4*)(experts + tok * 128 + h * 16 + fq * 4) = make_int4(ex4[0], ex4[1], ex4[2], ex4[3]);
    *(float4*)(gates + tok * 128 + h * 16 + fq * 4) = make_float4(g4[0], g4[1], g4[2], g4[3]);
    __builtin_amdgcn_wave_barrier();
  }
}

#define XB_TMO      128
#define XB_XCNT(j)  (256  + 64 * (j))
#define XB_XSUB(j)  (1280 + 64 * (j))
#define XB_XGEN(j)  (2304 + 64 * (j))
#define XB_TOP      3328
#define XB_TOPGEN   3392
#define XCD_BAR_WORDS 3456
#define XB_SPIN_CAP (1u << 18)
#define LAS __attribute__((address_space(3)))
__device__ __forceinline__ unsigned xb_ld(unsigned* p)              { return __hip_atomic_load(p, __ATOMIC_RELAXED, __HIP_MEMORY_SCOPE_AGENT); }
__device__ __forceinline__ unsigned xb_add(unsigned* p, unsigned v) { return __hip_atomic_fetch_add(p, v, __ATOMIC_RELAXED, __HIP_MEMORY_SCOPE_AGENT); }
__device__ __forceinline__ unsigned xb_xcc_id() { return (unsigned)__builtin_amdgcn_s_getreg((3 << 11) | 20) & 0xFu; }
#define XB_SPIN(cond, bar) do { unsigned _sp = 0; while (cond) { __builtin_amdgcn_s_sleep(1); \
    if ((++_sp & 255u) == 0u) { if (xb_ld(&(bar)[XB_TMO])) break; if (_sp > XB_SPIN_CAP) { atomicAdd(&(bar)[XB_TMO], 1u); break; } } } } while (0)
struct XcdBarrier { unsigned* bar; unsigned x; volatile LAS unsigned* st; };
__device__ __forceinline__ XcdBarrier xcd_barrier_post(unsigned* bar, volatile LAS unsigned* st) {
    XcdBarrier b; b.bar = bar; b.x = xb_xcc_id(); b.st = st;
    if (tid_() == 0) st[2] = xb_add(&bar[XB_XCNT(b.x)], 1u);
    return b;
}
__device__ __forceinline__ void xcd_barrier_complete(unsigned* bar, unsigned x, unsigned& nloc, unsigned& nx) {
    const unsigned G = gridDim.x * gridDim.y * gridDim.z;
    unsigned sum, cnt, mine, sp = 0u;
    for (;;) {
        sum = 0u; cnt = 0u; mine = 0u;
#pragma unroll
        for (unsigned j = 0; j < 16; ++j) { const unsigned c = xb_ld(&bar[XB_XCNT(j)]); sum += c; cnt += (c > 0u) ? 1u : 0u; mine = (j == x) ? c : mine; }
        if (sum == G) break;
        __builtin_amdgcn_s_sleep(1);
        if ((++sp & 255u) == 0u) { if (xb_ld(&bar[XB_TMO])) break; if (sp > XB_SPIN_CAP) { atomicAdd(&bar[XB_TMO], 1u); break; } }
    }
    nloc = mine > 0u ? mine : 1u; nx = cnt > 0u ? cnt : 1u;
}
__device__ __forceinline__ void xcd_barrier(const XcdBarrier& b) {
    asm volatile("s_waitcnt vmcnt(0)" ::: "memory");
    __syncthreads();
    if (tid_() == 0) {
        unsigned* bar = b.bar;
        __builtin_amdgcn_s_waitcnt(0);
        unsigned nloc = b.st[0], nx = b.st[1];
        if (nloc == 0u) { xcd_barrier_complete(bar, b.x, nloc, nx); b.st[0] = nloc; b.st[1] = nx; }
        const unsigned old = xb_add(&bar[XB_XSUB(b.x)], 1u);
        const unsigned gen = old / nloc;
        if (old + 1u == (gen + 1u) * nloc) {
            __builtin_amdgcn_fence(__ATOMIC_RELEASE, "agent");
            asm volatile("s_waitcnt vmcnt(0)" ::: "memory");
            const unsigned og = xb_add(&bar[XB_TOP], 1u);
            const unsigned tg = og / nx;
            if (og + 1u == (tg + 1u) * nx) xb_add(&bar[XB_TOPGEN], 1u);
            else XB_SPIN(xb_ld(&bar[XB_TOPGEN]) == tg, bar);
            __builtin_amdgcn_fence(__ATOMIC_ACQUIRE, "agent");
            xb_add(&bar[XB_XGEN(b.x)], 1u);
            asm volatile("s_waitcnt vmcnt(0)" ::: "memory");
        } else {
            XB_SPIN(xb_ld(&bar[XB_XGEN(b.x)]) == gen, bar);
            __builtin_amdgcn_fence(__ATOMIC_ACQUIRE, "agent");
            asm volatile("s_waitcnt vmcnt(0)" ::: "memory");
        }
    }
    __syncthreads();
}

__device__ __forceinline__ void dec16(u32x4 q, f32x2 (&v)[8]) {
#pragma unroll
  for (int k = 0; k < 4; ++k) {
    v[2 * k] = __builtin_amdgcn_cvt_pk_f32_fp8((int)q[k], false);
    v[2 * k + 1] = __builtin_amdgcn_cvt_pk_f32_fp8((int)q[k], true);
  }
}
__device__ __forceinline__ void xcd_slice(const P& p, int xcc, int xrank, int& x, int& rank, int& nblk) {
  unsigned c[8]; unsigned sum = 0; bool all = true;
#pragma unroll
  for (int j = 0; j < 8; ++j) { c[j] = xb_ld(&p_bar[XB_XCNT(j)]); sum += c[j]; all = all && (c[j] > 0u); }
  if (all && sum == gridDim.x) {
    x = xcc; rank = xrank;
    unsigned m = c[0];
#pragma unroll
    for (int j = 1; j < 8; ++j) m = (j == xcc) ? c[j] : m;
    nblk = (int)m;
  } else {
    x = blockIdx.x & 7; rank = blockIdx.x >> 3; nblk = (gridDim.x + 7 - x) >> 3;
  }
}

__device__ void ph_expert_u(const P& p, int xcc, int xrank) {
  const int lane = tid_() & 63, wid = tid_() >> 6, g = lane >> 3, cc = lane & 7;
  int x, rank, nblk;
  xcd_slice(p, xcc, xrank, x, rank, nblk);
  const int nw = nblk * 4, w0 = rank * 4 + wid;
  const int* experts = (const int*)p_mix + g;
  float* partial = (float*)p_proj + (size_t)x * TT * 128 + g;
  const unsigned char* tab = p_U8 + (size_t)x * 16384 * 128 + cc * 16;
  const u16* cbase = p_Abf + x * 128 + cc * 16;
  auto load_ex = [&](int t, int (&ex)[16]) {
    t = t < TT ? t : TT - 1;
#pragma unroll
    for (int i = 0; i < 16; ++i) ex[i] = experts[(size_t)t * 128 + i * 8];
  };
  auto load_c = [&](int t, u32x4& c0, u32x4& c1) {
    t = t < TT ? t : TT - 1;
    c0 = *(const u32x4*)(cbase + (size_t)t * DM); c1 = *(const u32x4*)(cbase + (size_t)t * DM + 8);
  };
  auto dot8 = [&](float (&sm)[16], int hf, const f32x2 (&cf)[8], const u32x4 (&rows)[8]) {
#pragma unroll
    for (int i = 0; i < 8; ++i) {
      f32x2 v[8];
      dec16(rows[i], v);
      f32x2 s2 = cf[0] * v[0];
#pragma unroll
      for (int k = 1; k < 8; ++k) s2 += cf[k] * v[k];
      sm[hf * 8 + i] = s2[0] + s2[1];
    }
  };
  const int slot0 = ((cc >> 2) & 1) * 8 + ((cc >> 1) & 1) * 4 + (cc & 1) * 2;
  auto reduce_store = [&](int t, float (&sm)[16]) {
    const bool h2 = (cc & 4) != 0, h1 = (cc & 2) != 0, h0 = (cc & 1) != 0;
#pragma unroll
    for (int k = 0; k < 8; ++k) {
      float send = h2 ? sm[k] : sm[k + 8]; float keep = h2 ? sm[k + 8] : sm[k];
      sm[k] = keep + __int_as_float(__builtin_amdgcn_ds_swizzle(__float_as_int(send), 0x101F));
    }
#pragma unroll
    for (int k = 0; k < 4; ++k) { float send = h1 ? sm[k] : sm[k + 4]; float keep = h1 ? sm[k + 4] : sm[k]; sm[k] = keep + dpp_f<DPP_XOR2>(send); }
#pragma unroll
    for (int k = 0; k < 2; ++k) { float send = h0 ? sm[k] : sm[k + 2]; float keep = h0 ? sm[k + 2] : sm[k]; sm[k] = keep + dpp_f<DPP_XOR1>(send); }
    partial[(size_t)t * 128 + slot0 * 8] = sm[0];
    partial[(size_t)t * 128 + slot0 * 8 + 8] = sm[1];
  };
  int t = w0;
  if (t >= TT) return;
  int exU[16], exN[16]; u32x4 rP[8], rQ[8]; u32x4 c0, c1, n0, n1;
  load_ex(t, exU); load_c(t, c0, c1);
#pragma unroll
  for (int i = 0; i < 8; ++i) rP[i] = *(const u32x4*)(tab + (size_t)exU[i] * 128);
  load_ex(t + nw, exN); load_c(t + nw, n0, n1);
  for (; t < TT; t += nw) {
#pragma unroll
    for (int i = 0; i < 8; ++i) rQ[i] = *(const u32x4*)(tab + (size_t)exU[8 + i] * 128);
    f32x2 cf[8];
#pragma unroll
    for (int k = 0; k < 4; ++k) { cf[k] = f32x2{bflo(c0[k]), bfhi(c0[k])}; cf[4 + k] = f32x2{bflo(c1[k]), bfhi(c1[k])}; }
    float sm[16];
    __builtin_amdgcn_sched_barrier(0);
    dot8(sm, 0, cf, rP);
    __builtin_amdgcn_sched_barrier(0);
#pragma unroll
    for (int i = 0; i < 8; ++i) rP[i] = *(const u32x4*)(tab + (size_t)exN[i] * 128);
    __builtin_amdgcn_sched_barrier(0);
    dot8(sm, 1, cf, rQ);
    __builtin_amdgcn_sched_barrier(0);
    reduce_store(t, sm);
    __builtin_amdgcn_sched_barrier(0);
#pragma unroll
    for (int i = 0; i < 16; ++i) exU[i] = exN[i];
    c0 = n0; c1 = n1;
    load_ex(t + 2 * nw, exN); load_c(t + 2 * nw, n0, n1);
  }
}

__device__ void ph_expert_red(const P& p) {
  const int lane = tid_() & 63, wid = tid_() >> 6;
  float* gates = (float*)(p_mix) + (size_t)TT * 128;
  const float* partial = (const float*)p_proj;
  for (int it = blockIdx.x; it < TT / 4; it += gridDim.x) {
    const size_t t = (size_t)it * 4 + wid;
#pragma unroll
    for (int hf = 0; hf < 2; ++hf) {
      float a = 0.f;
#pragma unroll
      for (int x = 0; x < 8; ++x) a += partial[((size_t)x * TT + t) * 128 + hf * 64 + lane];
      a *= (1.f / SU) * rsqrtf(p_ssq2[t] * (1.f / 1024.f) + EPS);
      float act = 0.5f * a * (1.f + erff(a * 0.70710678118654752f));
      gates[t * 128 + hf * 64 + lane] *= act;
    }
  }
}

__device__ void ph_expert_v(const P& p, int xcc, int xrank) {
  const int lane = tid_() & 63, wid = tid_() >> 6, g = lane >> 3, cc = lane & 7;
  int x, rank, nblk;
  xcd_slice(p, xcc, xrank, x, rank, nblk);
  const int nw = nblk * 4, w0 = rank * 4 + wid;
  const int* experts = (const int*)p_mix + g;
  const float* gates = (const float*)(p_mix) + (size_t)TT * 128 + g;
  const unsigned char* tab = p_V8 + (size_t)x * 16384 * 128 + cc * 16;
  const int col = x * 128 + cc * 16 + ((g >> 2) & 1) * 8 + ((g >> 1) & 1) * 4 + (g & 1) * 2;
  const float gn0 = p.norm_ple[col], gn1 = p.norm_ple[col + 1];
  auto load_ex = [&](int t, int (&ex)[16]) {
    t = t < TT ? t : TT - 1;
#pragma unroll
    for (int i = 0; i < 16; ++i) ex[i] = experts[(size_t)t * 128 + i * 8];
  };
  auto load8 = [&](int t, int hf, const int (&ex)[16], u32x4 (&rows)[8], float (&wv)[8]) {
    t = t < TT ? t : TT - 1;
#pragma unroll
    for (int i = 0; i < 8; ++i) { rows[i] = *(const u32x4*)(tab + (size_t)ex[hf * 8 + i] * 128); wv[i] = gates[(size_t)t * 128 + (hf * 8 + i) * 8]; }
  };
  auto acc8 = [&](f32x2 (&y2)[8], const float (&wv)[8], const u32x4 (&rows)[8]) {
#pragma unroll
    for (int i = 0; i < 8; ++i) {
      f32x2 v[8];
      dec16(rows[i], v);
      const f32x2 w2 = f32x2{wv[i], wv[i]};
#pragma unroll
      for (int k = 0; k < 8; ++k) y2[k] += w2 * v[k];
    }
  };
  auto finish = [&](int t, float2 hv, const f32x2 (&y2)[8]) {
    float y[16];
#pragma unroll
    for (int k = 0; k < 8; ++k) { y[2 * k] = y2[k][0]; y[2 * k + 1] = y2[k][1]; }
    {
      const bool h5 = (lane & 32) != 0;
#pragma unroll
      for (int k = 0; k < 8; ++k) { float send = h5 ? y[k] : y[k + 8]; float keep = h5 ? y[k + 8] : y[k]; y[k] = keep + __shfl_xor(send, 32); }
      const bool h4 = (lane & 16) != 0;
#pragma unroll
      for (int k = 0; k < 4; ++k) { float send = h4 ? y[k] : y[k + 4]; float keep = h4 ? y[k + 4] : y[k]; y[k] = keep + __shfl_xor(send, 16); }
      const bool h3 = (lane & 8) != 0;
#pragma unroll
      for (int k = 0; k < 2; ++k) { float send = h3 ? y[k] : y[k + 2]; float keep = h3 ? y[k + 2] : y[k]; y[k] = keep + __shfl_xor(send, 8); }
    }
    hv.x += y[0] * (1.f / SV); hv.y += y[1] * (1.f / SV);
    *(unsigned*)(p_h16 + (size_t)t * DM + col) = pack2(hv.x, hv.y);
    float ss = wave_sum(hv.x * hv.x + hv.y * hv.y);
    if (lane == 0) atomicAdd(p_ssq + t, ss);
    *(unsigned*)(p_Abf + (size_t)t * DM + col) = pack2(hv.x * gn0, hv.y * gn1);
  };
  int t = w0;
  if (t >= TT) return;
  int exU[16], exN[16]; u32x4 rP[8], rQ[8]; float wP[8], wQ[8];
  load_ex(t, exU);
  load8(t, 0, exU, rP, wP);
  load_ex(t + nw, exN);
  for (; t < TT; t += nw) {
    load8(t, 1, exU, rQ, wQ);
    const unsigned hvb = *(const unsigned*)(p_h16 + (size_t)t * DM + col);
    const float2 hv0 = make_float2(bflo(hvb), bfhi(hvb));
    f32x2 y2[8];
#pragma unroll
    for (int k = 0; k < 8; ++k) y2[k] = f32x2{0.f, 0.f};
    acc8(y2, wP, rP);
    load8(t + nw, 0, exN, rP, wP);
    acc8(y2, wQ, rQ);
    finish(t, hv0, y2);
#pragma unroll
    for (int i = 0; i < 16; ++i) exU[i] = exN[i];
    load_ex(t + 2 * nw, exN);
  }
}

__global__ void __launch_bounds__(256, 2) mega(P p) {
  __shared__ __attribute__((aligned(16))) float lds_f[14340];
  cg::grid_group grid = cg::this_grid();
  uint4& xb_words = *(uint4*)&lds_f[14336];
  if (tid_() == 0) xb_words = make_uint4(0u, 0u, 0u, 0u);
  __syncthreads();
  (void)xcd_barrier_post(p_bar, (volatile LAS unsigned*)&xb_words);
#ifndef PHMASK
#define PHMASK 0x3fff
#endif
#define PHON(i) ((PHMASK >> (i)) & 1)
#define PHASE(i, call) if (p.ph_lo <= (i) && (i) < p.ph_hi) { if (PHON(i)) { call; } if ((i) + 1 < p.ph_hi) { XcdBarrier xb_; xb_.bar = p_bar; xb_.x = xb_xcc_id(); xb_.st = (volatile LAS unsigned*)&xb_words; xcd_barrier(xb_); } }
  if (p.ph_lo <= 0 && 0 < p.ph_hi) { if (PHON(0)) { ph_prep(p, lds_f); } if (1 < p.ph_hi) grid.sync(); }
  PHASE(1, ph_gemm1(p, (u16*)lds_f))
  PHASE(2, ph_dnpre(p, lds_f))
  PHASE(3, ph_mixer(p, (u16*)lds_f))
  PHASE(4, ph_gatenorm(p))
  PHASE(5, ph_gemm2(p, (u16*)lds_f))
  PHASE(7, ph_gemm3(p, (u16*)lds_f))
  PHASE(8, ph_score(p, (int*)lds_f))
  PHASE(9, ph_expert_u(p, (int)xb_xcc_id(), (int)xb_words.z))
  PHASE(10, ph_expert_red(p))
  PHASE(11, ph_expert_v(p, (int)xb_xcc_id(), (int)xb_words.z))
  PHASE(12, ph_gemm4(p, (u16*)lds_f))
  PHASE(13, ph_final(p))
}

extern "C" void kernel_launch(void* const* d_in, const int* in_sizes, int n_in, void* d_out, int out_size, void* d_ws,
                              size_t ws_size, hipStream_t stream) {
  static int grid_blocks = 0;
  if (!grid_blocks) {
    int dev = 0, cus = 0, per_cu = 0;
    hipGetDevice(&dev);
    hipDeviceGetAttribute(&cus, hipDeviceAttributeMultiprocessorCount, dev);
    hipOccupancyMaxActiveBlocksPerMultiprocessor(&per_cu, mega, 256, 0);
    if (per_cu > 2) per_cu = 2;
    grid_blocks = cus * per_cu;
  }
  P p;
  memset(&p, 0, sizeof(p));
  const float** f = (const float**)&p;
  for (int i = 0; i < 26; ++i) f[i] = (const float*)d_in[i];
  p.out = (float*)d_out;
  p.ws = (char*)d_ws;
  p.ph_lo = 0; p.ph_hi = 14;
  hipMemsetAsync((char*)d_ws + 396283904ull, 0, (size_t)XCD_BAR_WORDS * 4, stream);
  void* args[] = {&p};
  hipError_t e = hipLaunchCooperativeKernel((void*)mega, dim3(grid_blocks), dim3(256), args, 0, stream);
  if (e != hipSuccess) fprintf(stderr, "cooperative launch failed: %s (grid %d)\n", hipGetErrorString(e), grid_blocks);
}
```
